# Optimizing an MI355X kernel written in HIP

```python
import jax, jax.numpy as jnp
from jax import lax

D_MODEL = 1024
BATCH = 8
SEQ = 2048
DEPTH = 4

GRID_W = 64
CTX_LEN = 256
NORM_EPS = 1e-6
N_MOD = 6
MASK_VALUE = -1e30

POOL_WINDOWS = (2, 4, 8, 16)
N_POOL_GROUPS = len(POOL_WINDOWS)
POOL_GROUP_DIM = D_MODEL // 8
D_POOL = N_POOL_GROUPS * POOL_GROUP_DIM

HEAD_DIM = 64
N_Q_HEADS = D_MODEL // 128
N_KV_HEADS = N_Q_HEADS // 4
GQA_GROUP = N_Q_HEADS // N_KV_HEADS
D_ATTN = N_Q_HEADS * HEAD_DIM
D_KV = N_KV_HEADS * HEAD_DIM
WINDOW = 128
ATTN_BLOCK = 128
ROPE_THETA = 10000.0
ROPE_AXIS_DIM = HEAD_DIM // 2
ROPE_FREQS = ROPE_AXIS_DIM // 2

CHUNK = 128
N_SG_GROUPS = 4
D_SG = D_MODEL // 2
SG_GROUP_DIM = D_SG // N_SG_GROUPS

N_BRANCHES = 3
OFF_Q = D_POOL
OFF_K = OFF_Q + D_ATTN
OFF_V = OFF_K + D_KV
OFF_U = OFF_V + D_KV
OFF_SV = OFF_U + D_SG
OFF_GATE = OFF_SV + D_SG
D_IN = OFF_GATE + N_BRANCHES * D_MODEL

D_FF = -(-8 * D_MODEL // (3 * 256)) * 256

kernel_name = 'hybrid_pool_swa_gmlp_dit'


def rmsnorm(x, gain):
    xf = x.astype(jnp.float32)
    y = xf * lax.rsqrt(jnp.mean(xf * xf, axis=-1, keepdims=True) + NORM_EPS)
    return (y * gain.astype(jnp.float32)).astype(x.dtype)


def modulate(x, gain, shift, scale):
    return rmsnorm(x, gain) * (1 + scale) + shift


def heads(t, n):
    return t.reshape(t.shape[:-1] + (n, HEAD_DIM))


def grid_rope_tables(rows):
    row = jnp.repeat(jnp.arange(rows), GRID_W).astype(jnp.float32)
    col = jnp.tile(jnp.arange(GRID_W), rows).astype(jnp.float32)
    inv_freq = ROPE_THETA ** (-jnp.arange(ROPE_FREQS, dtype=jnp.float32) / ROPE_FREQS)
    ang_r = row[:, None] * inv_freq[None, :]
    ang_c = col[:, None] * inv_freq[None, :]
    return (jnp.cos(ang_r), jnp.sin(ang_r), jnp.cos(ang_c), jnp.sin(ang_c))


def _rotate(xp, cos, sin):
    x1, x2 = xp[..., :ROPE_FREQS], xp[..., ROPE_FREQS:]
    cos = cos[None, :, None, :]
    sin = sin[None, :, None, :]
    return jnp.concatenate([x1 * cos - x2 * sin, x2 * cos + x1 * sin], axis=-1)


def rope_2d(t, tables):
    cos_r, sin_r, cos_c, sin_c = tables
    tf = t.astype(jnp.float32)
    out = jnp.concatenate([_rotate(tf[..., :ROPE_AXIS_DIM], cos_r, sin_r),
                           _rotate(tf[..., ROPE_AXIS_DIM:], cos_c, sin_c)], axis=-1)
    return out.astype(t.dtype)


def multiscale_pool(a, w_pool, pool_scale):
    bsz, length = a.shape[:2]
    af = a.astype(jnp.float32)
    csum = jnp.concatenate([jnp.zeros_like(af[:, :1]), jnp.cumsum(af, axis=1)], axis=1)
    pos = jnp.arange(length)
    means = []
    for g, w in enumerate(POOL_WINDOWS):
        lo = jnp.clip(pos - w // 2, 0, length)
        hi = jnp.clip(pos + (w - w // 2), 0, length)
        cg = csum[..., g * POOL_GROUP_DIM:(g + 1) * POOL_GROUP_DIM]
        cnt = (hi - lo).astype(jnp.float32)[:, None]
        means.append((cg[:, hi] - cg[:, lo]) / cnt)
    pooled = jnp.stack(means, axis=2) - af.reshape(bsz, length, N_POOL_GROUPS, POOL_GROUP_DIM)
    mixed = jnp.einsum('blgc,gcd->blgd', pooled.astype(a.dtype), w_pool)
    return mixed.reshape(bsz, length, D_POOL) * pool_scale


def banded(t, n_blocks):
    bsz = t.shape[0]
    tp = jnp.pad(t, ((0, 0), (ATTN_BLOCK, ATTN_BLOCK), (0, 0), (0, 0)))
    tb = tp.reshape(bsz, n_blocks + 2, ATTN_BLOCK, N_KV_HEADS, HEAD_DIM)
    return jnp.concatenate([tb[:, :-2], tb[:, 1:-1], tb[:, 2:]], axis=2)


def sink_column(sink, shape):
    s = sink.astype(jnp.float32).reshape(N_KV_HEADS, GQA_GROUP, 1, 1)
    return jnp.broadcast_to(s, shape[:-1] + (1,))


def window_attention_with_context(q, k, v, k_ctx, v_ctx, sink):
    bsz, length = q.shape[:2]
    nb = length // ATTN_BLOCK
    scale = HEAD_DIM ** -0.5
    qb = q.reshape(bsz, nb, ATTN_BLOCK, N_KV_HEADS, GQA_GROUP, HEAD_DIM)
    kb, vb = banded(k, nb), banded(v, nb)
    s_loc = jnp.einsum('bnqhgd,bnkhd->bnhgqk', qb, kb, preferred_element_type=jnp.float32) * scale
    q_pos = jnp.arange(nb)[:, None, None] * ATTN_BLOCK + jnp.arange(ATTN_BLOCK)[None, :, None]
    k_pos = jnp.arange(nb)[:, None, None] * ATTN_BLOCK - ATTN_BLOCK + jnp.arange(3 * ATTN_BLOCK)[None, None, :]
    valid = (jnp.abs(q_pos - k_pos) <= WINDOW) & (k_pos >= 0) & (k_pos < length)
    s_loc = jnp.where(valid[None, :, None, None], s_loc, MASK_VALUE)
    s_ctx = jnp.einsum('bnqhgd,bchd->bnhgqc', qb, k_ctx, preferred_element_type=jnp.float32) * scale
    logits = jnp.concatenate([s_loc, s_ctx, sink_column(sink, s_loc.shape)], axis=-1)
    p = jax.nn.softmax(logits, axis=-1).astype(v.dtype)
    n_loc = 3 * ATTN_BLOCK
    n_ctx = k_ctx.shape[1]
    out = (jnp.einsum('bnhgqk,bnkhd->bnqhgd', p[..., :n_loc], vb)
           + jnp.einsum('bnhgqc,bchd->bnqhgd', p[..., n_loc:n_loc + n_ctx], v_ctx))
    return out.reshape(bsz, length, D_ATTN)


def context_self_attention(q, k, v, sink):
    bsz, n = q.shape[:2]
    scale = HEAD_DIM ** -0.5
    qg = q.reshape(bsz, n, N_KV_HEADS, GQA_GROUP, HEAD_DIM)
    s = jnp.einsum('bqhgd,bkhd->bhgqk', qg, k, preferred_element_type=jnp.float32) * scale
    p = jax.nn.softmax(jnp.concatenate([s, sink_column(sink, s.shape)], axis=-1), axis=-1)
    out = jnp.einsum('bhgqk,bkhd->bqhgd', p[..., :n].astype(v.dtype), v)
    return out.reshape(bsz, n, D_ATTN)


def spatial_gating(u, v, v_gain, w_spatial, b_spatial):
    bsz, length = u.shape[:2]
    nc = length // CHUNK
    vn = rmsnorm(v, v_gain).reshape(bsz, nc, CHUNK, N_SG_GROUPS, SG_GROUP_DIM)
    mixed = jnp.einsum('gpr,bnrgc->bnpgc', w_spatial, vn) + b_spatial.T[:, :, None]
    return u * mixed.reshape(bsz, length, D_SG)


def mixer_merge(z, y_attn, w_pool, pool_scale, sg_v_gain, w_spatial, b_spatial,
                w_br_pool, w_br_attn, w_br_sg, w_out):
    y_pool = multiscale_pool(z[..., :OFF_Q], w_pool, pool_scale)
    y_sg = spatial_gating(jax.nn.gelu(z[..., OFF_U:OFF_SV]), jax.nn.gelu(z[..., OFF_SV:OFF_GATE]),
                          sg_v_gain, w_spatial, b_spatial)
    g = jax.nn.sigmoid(z[..., OFF_GATE:].reshape(z.shape[:-1] + (N_BRANCHES, D_MODEL)))
    y = (g[..., 0, :] * (y_pool @ w_br_pool)
         + g[..., 1, :] * (y_attn @ w_br_attn)
         + g[..., 2, :] * (y_sg @ w_br_sg))
    return y @ w_out


def swiglu(h, w_in, w_out):
    gu = h @ w_in
    return (jax.nn.silu(gu[..., :D_FF]) * gu[..., D_FF:]) @ w_out


def setup_inputs(seed: int = 0) -> dict:
    key = jax.random.key(seed)
    ks = jax.random.split(key, 24)
    f32 = jnp.float32

    def nrm(k, shape, scale):
        return jax.random.normal(k, shape, f32) * scale

    def gain(k, shape):
        return 1.0 + 0.02 * jax.random.normal(k, shape, f32)

    return {
        'x': nrm(ks[0], (BATCH, SEQ, D_MODEL), 1.0),
        'c': nrm(ks[1], (BATCH, D_MODEL), 1.0),
        'ctx': nrm(ks[2], (BATCH, CTX_LEN, D_MODEL), 1.0),
        'c_ctx': nrm(ks[3], (D_MODEL,), 1.0),
        'w_mod': nrm(ks[4], (DEPTH, D_MODEL, N_MOD * D_MODEL), 0.5 * D_MODEL ** -0.5),
        'b_mod': nrm(ks[5], (DEPTH, N_MOD * D_MODEL), 0.02),
        'norm1_gain': gain(ks[6], (DEPTH, D_MODEL)),
        'norm2_gain': gain(ks[7], (DEPTH, D_MODEL)),
        'w_in': nrm(ks[8], (DEPTH, D_MODEL, D_IN), D_MODEL ** -0.5),
        'w_pool': nrm(ks[9], (DEPTH, N_POOL_GROUPS, POOL_GROUP_DIM, POOL_GROUP_DIM), POOL_GROUP_DIM ** -0.5),
        'pool_scale': gain(ks[10], (DEPTH, D_POOL)),
        'attn_sink': nrm(ks[11], (DEPTH, N_Q_HEADS), 0.5),
        'sg_v_gain': gain(ks[12], (DEPTH, D_SG)),
        'w_spatial': nrm(ks[13], (DEPTH, N_SG_GROUPS, CHUNK, CHUNK), CHUNK ** -0.5),
        'b_spatial': gain(ks[14], (DEPTH, N_SG_GROUPS, CHUNK)),
        'w_br_pool': nrm(ks[15], (DEPTH, D_POOL, D_MODEL), D_POOL ** -0.5),
        'w_br_attn': nrm(ks[16], (DEPTH, D_ATTN, D_MODEL), D_ATTN ** -0.5),
        'w_br_sg': nrm(ks[17], (DEPTH, D_SG, D_MODEL), D_SG ** -0.5),
        'w_out': nrm(ks[18], (DEPTH, D_MODEL, D_MODEL), D_MODEL ** -0.5),
        'w_ffn_in': nrm(ks[19], (DEPTH, D_MODEL, 2 * D_FF), D_MODEL ** -0.5),
        'w_ffn_out': nrm(ks[20], (DEPTH, D_FF, D_MODEL), D_FF ** -0.5),
        'final_gain': gain(ks[21], (D_MODEL,)),
    }


def reference(x, c, ctx, c_ctx, w_mod, b_mod, norm1_gain, norm2_gain, w_in, w_pool, pool_scale,
              attn_sink, sg_v_gain, w_spatial, b_spatial, w_br_pool, w_br_attn, w_br_sg, w_out,
              w_ffn_in, w_ffn_out, final_gain):
    rows = x.shape[1] // GRID_W
    rope = grid_rope_tables(rows)
    cx = ctx
    sc = jax.nn.silu(c)
    scc = jax.nn.silu(c_ctx)
    for i in range(DEPTH):
        last = i == DEPTH - 1
        mod_x = jnp.split((sc @ w_mod[i] + b_mod[i])[:, None, :], N_MOD, axis=-1)
        mod_c = jnp.split((scc @ w_mod[i] + b_mod[i])[None, None, :], N_MOD, axis=-1)
        layer = (w_pool[i], pool_scale[i], sg_v_gain[i], w_spatial[i], b_spatial[i],
                 w_br_pool[i], w_br_attn[i], w_br_sg[i], w_out[i])

        hc = modulate(cx, norm1_gain[i], mod_c[0], mod_c[1])
        if last:
            zc = hc @ w_in[i, :, OFF_K:OFF_U]
            kc, vc = zc[..., :D_KV], zc[..., D_KV:]
        else:
            zc = hc @ w_in[i]
            kc, vc = zc[..., OFF_K:OFF_V], zc[..., OFF_V:OFF_U]
        kc, vc = heads(kc, N_KV_HEADS), heads(vc, N_KV_HEADS)

        hx = modulate(x, norm1_gain[i], mod_x[0], mod_x[1])
        zx = hx @ w_in[i]
        qx = rope_2d(heads(zx[..., OFF_Q:OFF_K], N_Q_HEADS), rope)
        kx = rope_2d(heads(zx[..., OFF_K:OFF_V], N_KV_HEADS), rope)
        vx = heads(zx[..., OFF_V:OFF_U], N_KV_HEADS)
        attn_x = window_attention_with_context(qx, kx, vx, kc, vc, attn_sink[i])
        x = x + mod_x[2] * mixer_merge(zx, attn_x, *layer)
        x = x + mod_x[5] * swiglu(modulate(x, norm2_gain[i], mod_x[3], mod_x[4]), w_ffn_in[i], w_ffn_out[i])

        if not last:
            attn_c = context_self_attention(heads(zc[..., OFF_Q:OFF_K], N_Q_HEADS), kc, vc, attn_sink[i])
            cx = cx + mod_c[2] * mixer_merge(zc, attn_c, *layer)
            cx = cx + mod_c[5] * swiglu(modulate(cx, norm2_gain[i], mod_c[3], mod_c[4]), w_ffn_in[i], w_ffn_out[i])
    return rmsnorm(x, final_gain)
```

```cpp
#include <hip/hip_runtime.h>
#include <hip/hip_cooperative_groups.h>
#include <cstdio>
#include <cstdint>
namespace cg = cooperative_groups;
namespace pg8 {
#define PG8_LAS __attribute__((address_space(3)))
typedef unsigned short bf16_t;
typedef short bf16x8 __attribute__((ext_vector_type(8)));
typedef float f32x4 __attribute__((ext_vector_type(4)));
typedef unsigned u32x4 __attribute__((ext_vector_type(4)));
constexpr int BM = 256, BK = 64, HALF = 128, HTB = HALF * BK * 2  , STAGE_BYTES = 8 * HTB, NXCD = 8, WGM = 8;

__host__ __device__ __forceinline__ int lds_byte(int r, int c) { const int st = (r >> 4) * 2 + (c >> 5), rr = r & 15, cc = c & 31, ob = rr * 64 + cc * 2; return st * 1024 + (ob ^ (((ob >> 9) & 1) << 5)); }
__host__ __device__ __forceinline__ void stage_rc(int b, int& R, int& C) { const int st = b / 1024, sb = b % 1024, swz = sb ^ (((sb >> 9) & 1) << 5); R = (st >> 1) * 16 + swz / 64; C = (st & 1) * 32 + (swz % 64) / 2; }
__host__ __device__ __forceinline__ int perm32(int rho) { const int n = rho >> 4, i = rho & 15; return 8 * (i >> 2) + 4 * n + (i & 3); }

struct Unit { int pm, pn, k0b, nt; };
struct Gemm { const bf16_t* A; const bf16_t* Bt; int M, N, K; };

struct StaticOrder {
    int nM, nN, nwg, G, c;
    __host__ __device__ __forceinline__ void init(int M, int N, int G_, int c_) { nM = M / BM; nN = N / BM; nwg = nM * nN; G = G_; c = c_; }
    __host__ __device__ __forceinline__ bool next(int i, Unit& u) const {
        const long L = (long)i * G + c; if (L >= nwg) return false;
        int wgid = (int)L; { const int q = nwg / NXCD, r = nwg % NXCD, xcd = wgid % NXCD, off = wgid / NXCD; wgid = (xcd < r ? xcd * (q + 1) : r * (q + 1) + (xcd - r) * q) + off; }
        const int nig = WGM * nN, gid = wgid / nig, fm = gid * WGM, gsz = (nM - fm) < WGM ? (nM - fm) : WGM;
        u.pm = fm + ((wgid % nig) % gsz); u.pn = (wgid % nig) / gsz; u.k0b = 0; u.nt = 0; return true;
    }
    __device__ __forceinline__ void a_ready(const Unit&) const {}
    __device__ __forceinline__ void done(const Unit&) const {}
};

template <class Epi, class Sched, bool ALIGN_EPI = false, bool SP2 = false>
__device__ __forceinline__ void gemm_phase(PG8_LAS unsigned char* lds, const Gemm g, const Sched& S, const Epi& E, const int tid) {
    const int  wid = __builtin_amdgcn_readfirstlane(tid >> 6), lane = tid & 63, wr = wid >> 2, wc = wid & 3, fr = lane & 15, fq = lane >> 4;
    const int K = g.K, nt = K / BK;
    unsigned voffA[2], voffB[2];
#pragma unroll
    for (int i = 0; i < 2; ++i) { int R, C; stage_rc(tid * 16 + i * 8192, R, C); const int Rb = Epi::PERM ? ((R & ~31) + perm32(R & 31)) : R;
        voffA[i] = (unsigned)(R * K + C) * 2u; voffB[i] = (unsigned)(Rb * K + C) * 2u; }
    const size_t kstep = (size_t)(BK * 2);
    const size_t hstep = (size_t)HALF * K * 2;
    const size_t tstep = 2 * hstep;
    const unsigned ldsw = (unsigned)wid * 1024u;
    const int aoff = lds_byte(wr * 64 + fr, fq * 8), boff = lds_byte(wc * 32 + fr, fq * 8);
#define PG8_SA(b, h) (((b) * 2 + (h)) * HTB)
#define PG8_SB(b, h) ((4 + (b) * 2 + (h)) * HTB)
#define PG8_STAGE(bufoff, gbase, voff) do { _Pragma("unroll") for (int _i = 0; _i < 2; ++_i) \
        __builtin_amdgcn_global_load_lds((const unsigned*)((const char*)(gbase) + (voff)[_i]), (PG8_LAS unsigned*)(lds + (bufoff) + ldsw + _i * 8192), 16, 0, 0); } while (0)
#define PG8_LDA(dst, b, h) do { _Pragma("unroll") for (int m = 0; m < 4; ++m) _Pragma("unroll") for (int k = 0; k < 2; ++k) dst[m][k] = *(const PG8_LAS bf16x8*)(lds + PG8_SA(b, h) + aoff + m * 2048 + k * 1024); } while (0)
#define PG8_LDB(dst, b, h) do { _Pragma("unroll") for (int n = 0; n < 2; ++n) _Pragma("unroll") for (int k = 0; k < 2; ++k) dst[n][k] = *(const PG8_LAS bf16x8*)(lds + PG8_SB(b, h) + boff + n * 2048 + k * 1024); } while (0)
#define PG8_MMA(ai, bj, At, Bt) do { __builtin_amdgcn_s_setprio(1); _Pragma("unroll") for (int m = 0; m < 4; ++m) _Pragma("unroll") for (int n = 0; n < 2; ++n) _Pragma("unroll") for (int k = 0; k < 2; ++k) \
        acc[ai][bj][m][n] = __builtin_amdgcn_mfma_f32_16x16x32_bf16(Bt[n][k], At[m][k], acc[ai][bj][m][n], 0, 0, 0); __builtin_amdgcn_s_setprio(0); } while (0)
#define PG8_WAIT_V(n) asm volatile("s_waitcnt vmcnt(" #n ")" ::: "memory")
#define PG8_WAIT_L(n) asm volatile("s_waitcnt lgkmcnt(" #n ")" ::: "memory")
#define PG8_BAR __builtin_amdgcn_s_barrier()
#define PG8_SCHED __builtin_amdgcn_sched_barrier(0)
    Unit cur, nxt; int ui = 0;
    if (!S.next(0, cur)) return;
    f32x4 acc[2][2][4][2];
#pragma unroll
    for (int a = 0; a < 2; ++a)
#pragma unroll
        for (int b = 0; b < 2; ++b)
#pragma unroll
            for (int m = 0; m < 4; ++m)
#pragma unroll
                for (int n = 0; n < 2; ++n) acc[a][b][m][n] = (f32x4){0.f, 0.f, 0.f, 0.f};
    bf16x8 At[4][2], B0[2][2], B1[2][2];
    const char* cA = (const char*)g.A + (size_t)cur.pm * tstep + cur.k0b; const char* cB = (const char*)g.Bt + (size_t)cur.pn * tstep + cur.k0b;
    S.a_ready(cur);
    if constexpr (SP2) {
        PG8_STAGE(PG8_SB(0, 0), cB, voffB); PG8_STAGE(PG8_SB(0, 1), cB + hstep, voffB); PG8_STAGE(PG8_SA(0, 0), cA, voffA); PG8_STAGE(PG8_SA(0, 1), cA + hstep, voffA);
        if (wr == 1) PG8_BAR;
        PG8_WAIT_V(2); PG8_BAR;
        PG8_STAGE(PG8_SB(1, 0), cB + kstep, voffB); PG8_STAGE(PG8_SA(1, 0), cA + kstep, voffA); PG8_STAGE(PG8_SB(1, 1), cB + hstep + kstep, voffB);
        PG8_WAIT_V(6); PG8_BAR;
    } else {
        PG8_STAGE(PG8_SB(0, 0), cB, voffB); PG8_STAGE(PG8_SA(0, 0), cA, voffA); PG8_STAGE(PG8_SB(0, 1), cB + hstep, voffB); PG8_STAGE(PG8_SA(0, 1), cA + hstep, voffA);
        if (wr == 1) PG8_BAR;
        PG8_WAIT_V(4); PG8_BAR;
        PG8_STAGE(PG8_SB(1, 0), cB + kstep, voffB); PG8_STAGE(PG8_SA(1, 0), cA + kstep, voffA); PG8_STAGE(PG8_SB(1, 1), cB + hstep + kstep, voffB);
        PG8_WAIT_V(6); PG8_BAR;
    }
    for (;;) {
        const bool has_next = S.next(ui + 1, nxt);
        const char* nA = has_next ? (const char*)g.A + (size_t)nxt.pm * tstep + nxt.k0b : cA; const char* nB = has_next ? (const char*)g.Bt + (size_t)nxt.pn * tstep + nxt.k0b : cB;
        const int cnt = cur.nt ? cur.nt : nt;
        for (int t = 0; t < cnt; t += 2) {
            const bool last = (t == cnt - 2);
            const char* a1 = cA + (size_t)(t + 1) * kstep;
            const char* a2 = last ? nA : cA + (size_t)(t + 2) * kstep; const char* b2 = last ? nB : cB + (size_t)(t + 2) * kstep;
            const char* a3 = a2 + kstep; const char* b3 = b2 + kstep;
            if (last && has_next) S.a_ready(nxt);
            if constexpr (SP2) {
            PG8_LDB(B0, 0, 0); PG8_LDB(B1, 0, 1); PG8_SCHED; PG8_LDA(At, 0, 0); PG8_STAGE(PG8_SA(1, 1), a1 + hstep, voffA);
            PG8_WAIT_V(8); PG8_WAIT_L(0); PG8_BAR; PG8_MMA(0, 0, At, B0); PG8_MMA(0, 1, At, B1); PG8_BAR; PG8_SCHED;
            PG8_LDA(At, 0, 1); PG8_STAGE(PG8_SB(0, 0), b2, voffB); PG8_STAGE(PG8_SB(0, 1), b2 + hstep, voffB); PG8_STAGE(PG8_SA(0, 0), a2, voffA);
            PG8_WAIT_V(8); PG8_WAIT_L(0); PG8_BAR; PG8_MMA(1, 0, At, B0); PG8_MMA(1, 1, At, B1); PG8_BAR; PG8_SCHED;
            PG8_LDB(B0, 1, 0); PG8_LDB(B1, 1, 1); PG8_SCHED; PG8_LDA(At, 1, 0); PG8_STAGE(PG8_SA(0, 1), a2 + hstep, voffA);
            PG8_WAIT_V(8); PG8_WAIT_L(0); PG8_BAR; PG8_MMA(0, 0, At, B0); PG8_MMA(0, 1, At, B1); PG8_BAR; PG8_SCHED;
            PG8_LDA(At, 1, 1); PG8_STAGE(PG8_SB(1, 0), b3, voffB); PG8_STAGE(PG8_SB(1, 1), b3 + hstep, voffB); PG8_STAGE(PG8_SA(1, 0), a3, voffA);
            PG8_WAIT_V(8); PG8_WAIT_L(0); PG8_BAR; PG8_MMA(1, 0, At, B0); PG8_MMA(1, 1, At, B1); PG8_BAR; PG8_SCHED;
            } else {
            PG8_LDB(B0, 0, 0); PG8_SCHED; PG8_LDA(At, 0, 0); PG8_STAGE(PG8_SA(1, 1), a1 + hstep, voffA);
            PG8_WAIT_L(8); PG8_BAR; PG8_WAIT_L(0); PG8_MMA(0, 0, At, B0); PG8_BAR; PG8_SCHED;
            PG8_LDB(B1, 0, 1); PG8_STAGE(PG8_SB(0, 0), b2, voffB);
            PG8_BAR; PG8_WAIT_L(0); PG8_MMA(0, 1, At, B1); PG8_BAR;
            PG8_LDA(At, 0, 1); PG8_STAGE(PG8_SA(0, 0), a2, voffA);
            PG8_BAR; PG8_WAIT_L(0); PG8_MMA(1, 0, At, B0); PG8_BAR; PG8_SCHED;
            PG8_STAGE(PG8_SB(0, 1), b2 + hstep, voffB);
            PG8_WAIT_V(6); PG8_BAR; PG8_MMA(1, 1, At, B1); PG8_BAR;
            PG8_LDB(B0, 1, 0); PG8_SCHED; PG8_LDA(At, 1, 0); PG8_STAGE(PG8_SA(0, 1), a2 + hstep, voffA);
            PG8_WAIT_L(8); PG8_BAR; PG8_WAIT_L(0); PG8_MMA(0, 0, At, B0); PG8_BAR; PG8_SCHED;
            PG8_LDB(B1, 1, 1); PG8_STAGE(PG8_SB(1, 0), b3, voffB);
            PG8_BAR; PG8_WAIT_L(0); PG8_MMA(0, 1, At, B1); PG8_BAR;
            PG8_LDA(At, 1, 1); PG8_STAGE(PG8_SA(1, 0), a3, voffA);
            PG8_BAR; PG8_WAIT_L(0); PG8_MMA(1, 0, At, B0); PG8_BAR; PG8_SCHED;
            PG8_STAGE(PG8_SB(1, 1), b3 + hstep, voffB);
            PG8_WAIT_V(6); PG8_BAR; PG8_MMA(1, 1, At, B1); PG8_BAR;
            }
        }
        if constexpr (ALIGN_EPI) { if (wr == 0) PG8_BAR; }
        if constexpr (!Epi::AFTER_DRAIN) { E(acc, cur, wr, wc, fr, fq); S.done(cur); }
        else { if (has_next) { E(acc, cur, wr, wc, fr, fq); S.done(cur); } }
        if (!has_next) break;
#pragma unroll
        for (int a = 0; a < 2; ++a)
#pragma unroll
            for (int b = 0; b < 2; ++b)
#pragma unroll
                for (int m = 0; m < 4; ++m)
#pragma unroll
                    for (int n = 0; n < 2; ++n) acc[a][b][m][n] = (f32x4){0.f, 0.f, 0.f, 0.f};
        cur = nxt; cA = nA; cB = nB; ++ui;
        if constexpr (ALIGN_EPI) { if (wr == 1) PG8_BAR; }
    }
    PG8_WAIT_V(0);
    if constexpr (!ALIGN_EPI) { if (wr == 0) PG8_BAR; }
    PG8_BAR;
    if constexpr (Epi::AFTER_DRAIN) { E.fused(acc, cur, wr, wc, fr, fq, lds, wid, lane); S.done(cur); }
#undef PG8_SA
#undef PG8_SB
#undef PG8_STAGE
#undef PG8_LDA
#undef PG8_LDB
#undef PG8_MMA
#undef PG8_WAIT_V
#undef PG8_WAIT_L
#undef PG8_BAR
#undef PG8_SCHED
}
}
namespace pg8 {
struct Gemm3 { const bf16_t *A0, *A1, *A2, *B0, *B1, *B2; int M, N, K; };
template <class Epi, class Sched>
__device__ __forceinline__ void gemm_phase_h1(PG8_LAS unsigned char* lds, const Gemm3 g, const Sched& S, const Epi& E, const int tid) {
    const int wid = __builtin_amdgcn_readfirstlane(tid >> 6), lane = tid & 63, wr = wid >> 2, wc = wid & 3, fr = lane & 15, fq = lane >> 4;
    const int K = g.K, nt = K / BK;
    unsigned voff[2];
#pragma unroll
    for (int i = 0; i < 2; ++i) { int R, C; stage_rc(tid * 16 + i * 8192, R, C); voff[i] = (unsigned)(R * K + C) * 2u; }
    const size_t kstep = (size_t)(BK * 2);
    const size_t hstep = (size_t)HALF * K * 2;
    const size_t tstepA = 2 * hstep, tstepB = hstep;
    const unsigned ldsw = (unsigned)wid * 1024u;
    const int aoff = lds_byte(wr * 64 + fr, fq * 8), boff = lds_byte(wc * 32 + fr, fq * 8);
#define H1_SA(b, h) (((b) * 2 + (h)) * HTB)
#define H1_SB(b) ((4 + (b)) * HTB)
#define H1_STAGE(bufoff, gbase) do { _Pragma("unroll") for (int _i = 0; _i < 2; ++_i) \
        __builtin_amdgcn_global_load_lds((const unsigned*)((const char*)(gbase) + voff[_i]), (PG8_LAS unsigned*)(lds + (bufoff) + ldsw + _i * 8192), 16, 0, 0); } while (0)
#define H1_LDA(dst, b, h) do { _Pragma("unroll") for (int m = 0; m < 4; ++m) _Pragma("unroll") for (int k = 0; k < 2; ++k) dst[m][k] = *(const PG8_LAS bf16x8*)(lds + H1_SA(b, h) + aoff + m * 2048 + k * 1024); } while (0)
#define H1_LDB(dst, b) do { _Pragma("unroll") for (int n = 0; n < 2; ++n) _Pragma("unroll") for (int k = 0; k < 2; ++k) dst[n][k] = *(const PG8_LAS bf16x8*)(lds + H1_SB(b) + boff + n * 2048 + k * 1024); } while (0)
#define H1_MMA(ai) do { __builtin_amdgcn_s_setprio(1); _Pragma("unroll") for (int m = 0; m < 4; ++m) _Pragma("unroll") for (int n = 0; n < 2; ++n) _Pragma("unroll") for (int k = 0; k < 2; ++k) \
        acc[ai][m][n] = __builtin_amdgcn_mfma_f32_16x16x32_bf16(B0[n][k], At[m][k], acc[ai][m][n], 0, 0, 0); __builtin_amdgcn_s_setprio(0); } while (0)
#define H1_WAIT_V(n) asm volatile("s_waitcnt vmcnt(" #n ")" ::: "memory")
#define H1_WAIT_L(n) asm volatile("s_waitcnt lgkmcnt(" #n ")" ::: "memory")
#define H1_BAR __builtin_amdgcn_s_barrier()
#define H1_SCHED __builtin_amdgcn_sched_barrier(0)
    Unit cur, nxt; int ui = 0, br = 0;
    if (!S.next(0, cur)) return;
    f32x4 acc[2][4][2], tot[2][4][2];
#pragma unroll
    for (int a = 0; a < 2; ++a)
#pragma unroll
        for (int m = 0; m < 4; ++m)
#pragma unroll
            for (int n = 0; n < 2; ++n) { acc[a][m][n] = (f32x4){0.f, 0.f, 0.f, 0.f}; tot[a][m][n] = (f32x4){0.f, 0.f, 0.f, 0.f}; }
    bf16x8 At[4][2], B0[2][2];
    const char* cA = (const char*)g.A0 + (size_t)cur.pm * tstepA; const char* cB = (const char*)g.B0 + (size_t)cur.pn * tstepB;
    H1_STAGE(H1_SB(0), cB); H1_STAGE(H1_SA(0, 0), cA); H1_STAGE(H1_SA(0, 1), cA + hstep);
    if (wr == 1) H1_BAR;
    H1_WAIT_V(2); H1_BAR;
    H1_STAGE(H1_SB(1), cB + kstep); H1_STAGE(H1_SA(1, 0), cA + kstep);
    H1_WAIT_V(4); H1_BAR;
    for (;;) {
        bool has_next; int nbr;
        if (br < 2) { has_next = true; nxt = cur; nbr = br + 1; } else { has_next = S.next(ui + 1, nxt); nbr = 0; }
        const bf16_t* nAb = (nbr == 0) ? g.A0 : (nbr == 1 ? g.A1 : g.A2); const bf16_t* nBb = (nbr == 0) ? g.B0 : (nbr == 1 ? g.B1 : g.B2);
        const char* nA = has_next ? (const char*)nAb + (size_t)nxt.pm * tstepA : cA; const char* nB = has_next ? (const char*)nBb + (size_t)nxt.pn * tstepB : cB;
        for (int t = 0; t < nt; t += 2) {
            const bool last = (t == nt - 2);
            const char* a1 = cA + (size_t)(t + 1) * kstep;
            const char* a2 = last ? nA : cA + (size_t)(t + 2) * kstep; const char* b2 = last ? nB : cB + (size_t)(t + 2) * kstep;
            const char* a3 = a2 + kstep; const char* b3 = b2 + kstep;
            H1_LDB(B0, 0); H1_SCHED; H1_LDA(At, 0, 0); H1_STAGE(H1_SA(1, 1), a1 + hstep);
            H1_WAIT_V(6); H1_WAIT_L(0); H1_BAR; H1_MMA(0); H1_BAR; H1_SCHED;
            H1_LDA(At, 0, 1); H1_STAGE(H1_SB(0), b2); H1_STAGE(H1_SA(0, 0), a2);
            H1_WAIT_V(6); H1_WAIT_L(0); H1_BAR; H1_MMA(1); H1_BAR; H1_SCHED;
            H1_LDB(B0, 1); H1_SCHED; H1_LDA(At, 1, 0); H1_STAGE(H1_SA(0, 1), a2 + hstep);
            H1_WAIT_V(6); H1_WAIT_L(0); H1_BAR; H1_MMA(0); H1_BAR; H1_SCHED;
            H1_LDA(At, 1, 1); H1_STAGE(H1_SB(1), b3); H1_STAGE(H1_SA(1, 0), a3);
            H1_WAIT_V(6); H1_WAIT_L(0); H1_BAR; H1_MMA(1); H1_BAR; H1_SCHED;
        }
        if (wr == 0) H1_BAR;
        E.seg(acc, tot, cur, br, wr, wc, fr, fq);
        if (!has_next) break;
#pragma unroll
        for (int a = 0; a < 2; ++a)
#pragma unroll
            for (int m = 0; m < 4; ++m)
#pragma unroll
                for (int n = 0; n < 2; ++n) acc[a][m][n] = (f32x4){0.f, 0.f, 0.f, 0.f};
        if (br == 2) ++ui;
        cur = nxt; cA = nA; cB = nB; br = nbr;
        if (wr == 1) H1_BAR;
    }
    H1_WAIT_V(0);
    H1_BAR;
#undef H1_SA
#undef H1_SB
#undef H1_STAGE
#undef H1_LDA
#undef H1_LDB
#undef H1_MMA
#undef H1_WAIT_V
#undef H1_WAIT_L
#undef H1_BAR
#undef H1_SCHED
}
}

constexpr int DM = 1024, NBATCH = 8, SEQ = 2048, DEPTH = 4, CTXL = 256;
constexpr int ML = NBATCH * SEQ, MC = NBATCH * CTXL, MT = ML + MC;
constexpr int D_IN = 5376, D_FF = 2816;
constexpr float NORM_EPS = 1e-6f;
constexpr float LOG2E = 1.4426950408889634f;
constexpr float QSCALE = 0.125f * LOG2E;
constexpr int NWAVES = 8, NTHR = 512;
#ifndef MK_ONE_LAUNCH
#define MK_ONE_LAUNCH 1
#endif

constexpr size_t MiB = 1u << 20;
constexpr size_t WS_CTL = 0, CTL_ZERO_BYTES = 448 * 1024;
constexpr int CW_XCNT = 81920;
constexpr size_t WS_XSLOT = 2 * MiB + 262144;
constexpr size_t WS_MODV = 1 * MiB;
constexpr size_t WS_ROPE = 2 * MiB;
constexpr size_t WS_SSQ = 2 * MiB + 65536;
constexpr size_t WS_XC = 3 * MiB;
constexpr size_t WS_WB = 11 * MiB;
constexpr size_t WB_WIN = 0, WB_WBP = 11010048, WB_WBA = WB_WBP + MiB, WB_WBS = WB_WBA + MiB, WB_WOUT = WB_WBS + MiB,
                 WB_WFI = WB_WOUT + 2 * MiB, WB_WFO = WB_WFI + 11534336, WB_WSP = WB_WFO + 5767168, WB_END = WB_WSP + 131072;
static_assert(WB_END <= 34 * MiB, "weights");
constexpr size_t WS_H = 45 * MiB;
constexpr size_t WS_ZPOOL = 81 * MiB;
constexpr size_t WS_SV = 99 * MiB;
constexpr size_t WS_YACC = WS_H;
constexpr size_t WS_Q = 117 * MiB;
constexpr size_t WS_KB = 135 * MiB;
constexpr size_t WS_VT = WS_KB + 4718592;
constexpr size_t WS_U = 144 * MiB;
constexpr size_t WS_GATES = 162 * MiB;
constexpr size_t WS_ACT = WS_GATES;
constexpr size_t WS_POOLED = 270 * MiB;
constexpr size_t WS_YM = 288 * MiB;
constexpr size_t WS_YATT = 324 * MiB;
constexpr size_t WS_YSG = 342 * MiB;
constexpr size_t WS_SLAB = 81 * MiB;
constexpr size_t WS_XF = 360 * MiB;
constexpr size_t WS_END = 424 * MiB;
constexpr size_t VT_CTX_OFF = (size_t)NBATCH * 2 * 64 * SEQ;
constexpr int CW_BAR = 4096;

constexpr int RING_BYTES = 131072, LDSCTL_OFF = RING_BYTES, MISC_OFF = LDSCTL_OFF + 320, LDS_BYTES = 147456;

#define GAS __attribute__((address_space(1)))
#define LAS __attribute__((address_space(3)))
typedef unsigned short bf16_t;
typedef short bf16x8 __attribute__((ext_vector_type(8)));
typedef short s16x4 __attribute__((ext_vector_type(4)));
typedef float f32x4 __attribute__((ext_vector_type(4)));
typedef float f32x16 __attribute__((ext_vector_type(16)));
typedef unsigned u32x4 __attribute__((ext_vector_type(4)));
typedef unsigned u32x2 __attribute__((ext_vector_type(2)));
typedef float f32x2_t __attribute__((ext_vector_type(2)));
typedef __bf16 bf16x2_t __attribute__((ext_vector_type(2)));
__device__ __forceinline__ unsigned pk2(float lo, float hi) { f32x2_t v = {lo, hi}; bf16x2_t b = __builtin_convertvector(v, bf16x2_t); return __builtin_bit_cast(unsigned, b); }
__device__ __forceinline__ float bf2f(unsigned short v) { return __uint_as_float((unsigned)v << 16); }
__device__ __forceinline__ float bflo(unsigned w) { return __uint_as_float(w << 16); }
__device__ __forceinline__ float bfhi(unsigned w) { return __uint_as_float(w & 0xffff0000u); }
__device__ __forceinline__ void st4bf(bf16_t* p, f32x4 v) { u32x2 w; w.x = pk2(v[0], v[1]); w.y = pk2(v[2], v[3]); *(u32x2*)p = w; }
__device__ __forceinline__ void st8bf_x(bf16_t* p, f32x4 lo, f32x4 hi, bool odd) {
    unsigned a0 = pk2(lo[0], lo[1]), a1 = pk2(lo[2], lo[3]), b0 = pk2(hi[0], hi[1]), b1 = pk2(hi[2], hi[3]);
    auto r0 = __builtin_amdgcn_permlane16_swap(a0, b0, false, false); a0 = r0[0]; b0 = r0[1];
    auto r1 = __builtin_amdgcn_permlane16_swap(a1, b1, false, false); a1 = r1[0]; b1 = r1[1];
    *(u32x4*)(p + (odd ? 12 : 0)) = (u32x4){a0, a1, b0, b1};
}
__device__ __forceinline__ float fast_exp2(float x) { return __builtin_amdgcn_exp2f(x); }
__device__ __forceinline__ float fast_rcp(float x) { return __builtin_amdgcn_rcpf(x); }
__device__ __forceinline__ float sigmoidf_(float x) { return fast_rcp(1.f + fast_exp2(-LOG2E * x)); }
__device__ __forceinline__ float siluf_(float x) { return x * sigmoidf_(x); }
__device__ __forceinline__ float gelu_tanh(float x) { const float y = 1.5957691216057308f * (x + 0.044715f * x * x * x); return x * fast_rcp(1.f + fast_exp2(-LOG2E * y)); }
__device__ __forceinline__ float wave_sum(float v) {
#pragma unroll
    for (int o = 1; o < 64; o <<= 1) v += __shfl_xor(v, o);
    return v;
}

#define XB_TMO      128
#define XB_XCNT(j)  (256  + 64 * (j))
#define XB_XSUB(j)  (1280 + 64 * (j))
#define XB_XGEN(j)  (2304 + 64 * (j))
#define XB_TOP      3328
#define XB_TOPGEN   3392
#define XCD_BAR_WORDS 3456
#define XB_SPIN_CAP (1u << 18)

__device__ __forceinline__ unsigned xb_ld(unsigned* p)              { return __hip_atomic_load(p, __ATOMIC_RELAXED, __HIP_MEMORY_SCOPE_AGENT); }
__device__ __forceinline__ unsigned xb_add(unsigned* p, unsigned v) { return __hip_atomic_fetch_add(p, v, __ATOMIC_RELAXED, __HIP_MEMORY_SCOPE_AGENT); }
__device__ __forceinline__ unsigned xb_xcc_id() { return (unsigned)__builtin_amdgcn_s_getreg((3 << 11) | 20) & 0xFu; }
#define XB_SPIN(cond, bar) do { unsigned _sp = 0; while (cond) { __builtin_amdgcn_s_sleep(1); \
    if ((++_sp & 255u) == 0u) { if (xb_ld(&(bar)[XB_TMO])) break; if (_sp > XB_SPIN_CAP) { atomicAdd(&(bar)[XB_TMO], 1u); break; } } } } while (0)

struct XcdBarrier {
    unsigned* bar; unsigned x;
    volatile LAS unsigned* st;
};

__device__ __forceinline__ XcdBarrier xcd_barrier_post(unsigned* bar, volatile LAS unsigned* st) {
    XcdBarrier b; b.bar = bar; b.x = xb_xcc_id(); b.st = st;
    if (threadIdx.x == 0) (void)xb_add(&bar[XB_XCNT(b.x)], 1u);
    return b;
}
__device__ __forceinline__ void xcd_barrier_complete(unsigned* bar, unsigned x, unsigned& nloc, unsigned& nx) {
    const unsigned G = gridDim.x * gridDim.y * gridDim.z;
    unsigned sum, cnt, mine, sp = 0u;
    for (;;) {
        sum = 0u; cnt = 0u; mine = 0u;
#pragma unroll
        for (unsigned j = 0; j < 16; ++j) { const unsigned c = xb_ld(&bar[XB_XCNT(j)]); sum += c; cnt += (c > 0u) ? 1u : 0u; mine = (j == x) ? c : mine; }
        if (sum == G) break;
        __builtin_amdgcn_s_sleep(1);
        if ((++sp & 255u) == 0u) { if (xb_ld(&bar[XB_TMO])) break; if (sp > XB_SPIN_CAP) { atomicAdd(&bar[XB_TMO], 1u); break; } }
    }
    nloc = mine > 0u ? mine : 1u; nx = cnt > 0u ? cnt : 1u;
}

__device__ __forceinline__ void xcd_barrier(const XcdBarrier& b) {
    asm volatile("s_waitcnt vmcnt(0)" ::: "memory");
    __syncthreads();
    if (threadIdx.x == 0) {
        unsigned* bar = b.bar;
        __builtin_amdgcn_s_waitcnt(0);
        unsigned nloc = b.st[0], nx = b.st[1];
        if (nloc == 0u) { xcd_barrier_complete(bar, b.x, nloc, nx); b.st[0] = nloc; b.st[1] = nx; }
        const unsigned old = xb_add(&bar[XB_XSUB(b.x)], 1u);
        const unsigned gen = old / nloc;
        if (old + 1u == (gen + 1u) * nloc) {
            __builtin_amdgcn_fence(__ATOMIC_RELEASE, "agent");
            asm volatile("s_waitcnt vmcnt(0)" ::: "memory");
            const unsigned og = xb_add(&bar[XB_TOP], 1u);
            const unsigned tg = og / nx;
            if (og + 1u == (tg + 1u) * nx) xb_add(&bar[XB_TOPGEN], 1u);
            else XB_SPIN(xb_ld(&bar[XB_TOPGEN]) == tg, bar);
            __builtin_amdgcn_fence(__ATOMIC_ACQUIRE, "agent");
            xb_add(&bar[XB_XGEN(b.x)], 1u);
            asm volatile("s_waitcnt vmcnt(0)" ::: "memory");
        } else {
            XB_SPIN(xb_ld(&bar[XB_XGEN(b.x)]) == gen, bar);
            __builtin_amdgcn_fence(__ATOMIC_ACQUIRE, "agent");
            asm volatile("s_waitcnt vmcnt(0)" ::: "memory");
        }
    }
    __syncthreads();
}


struct Params {
    const float *x, *c, *ctx, *c_ctx, *w_mod, *b_mod, *n1g, *n2g, *w_in, *w_pool, *pool_scale, *sink, *sgg, *w_sp, *b_sp, *wbp, *wba, *wbs, *w_out, *wfi, *wfo, *fgain;
    float* out; unsigned char* ws; int ph_lo, ph_hi;
};

template <class F> struct EpiPair {
    static constexpr bool PERM = false, AFTER_DRAIN = false;
    F f;
    __device__ __forceinline__ void operator()(const pg8::f32x4 (&acc)[2][2][4][2], const pg8::Unit& u, int wr, int wc, int fr, int fq) const {
#pragma unroll
        for (int ai = 0; ai < 2; ++ai)
#pragma unroll
            for (int m = 0; m < 4; ++m) {
                const int row = u.pm * 256 + ai * 128 + wr * 64 + m * 16 + fr;
#pragma unroll
                for (int bj = 0; bj < 2; ++bj) {
                    const int c0 = u.pn * 256 + bj * 128 + wc * 32 + 4 * fq;
                    f(row, c0, acc[ai][bj][m][0], acc[ai][bj][m][1]);
                }
                asm volatile("" ::: "memory");
            }
    }
};

struct EpiE1 {
    static constexpr bool PERM = false, AFTER_DRAIN = false;
    unsigned char* ws; int roff, coff;
    template <int R> __device__ __forceinline__ void elem(int row, int c0, f32x4 v0, f32x4 v1) const {
        const bool odd = (c0 >> 2) & 1;
        if constexpr (R == 0) { bf16_t* o = (bf16_t*)(ws + WS_ZPOOL) + (size_t)row * 512 + c0; st8bf_x(o, v0, v1, odd); }
        else if constexpr (R == 1 || R == 2) {
            if (row < ML) {
                const float* rope = (const float*)(ws + WS_ROPE);
                const int t = row & (SEQ - 1); const int pos = (c0 & 32) ? (t & 63) : (t >> 6);
                const f32x4* rp = (const f32x4*)(rope + (pos * 16 + (c0 & 15)) * 2);
                const f32x4 r0 = rp[0], r1 = rp[1];
                f32x4 a, b;
                a[0] = v0[0] * r0[0] - v1[0] * r0[1]; b[0] = v1[0] * r0[0] + v0[0] * r0[1];
                a[1] = v0[1] * r0[2] - v1[1] * r0[3]; b[1] = v1[1] * r0[2] + v0[1] * r0[3];
                a[2] = v0[2] * r1[0] - v1[2] * r1[1]; b[2] = v1[2] * r1[0] + v0[2] * r1[1];
                a[3] = v0[3] * r1[2] - v1[3] * r1[3]; b[3] = v1[3] * r1[2] + v0[3] * r1[3];
                v0 = a; v1 = b;
            }
            if constexpr (R == 1) { v0 = v0 * QSCALE; v1 = v1 * QSCALE; bf16_t* o = (bf16_t*)(ws + WS_Q) + (size_t)row * 512 + (c0 - 512); st8bf_x(o, v0, v1, odd); }
            else { bf16_t* o = (bf16_t*)(ws + WS_KB) + (size_t)row * 128 + (c0 - 1024); st8bf_x(o, v0, v1, odd); }
        }
        else if constexpr (R == 3) {
            bf16_t* vt = (bf16_t*)(ws + WS_VT);
            const int cc = c0 - 1152, hk = cc >> 6, d = cc & 63; size_t base, stride;
            if (row < ML) { const int b = row >> 11, pos = row & (SEQ - 1); base = ((size_t)((b * 2 + hk) * 64 + d)) * SEQ + pos; stride = SEQ; }
            else { const int r = row - ML, b = r >> 8, pos = r & (CTXL - 1); base = VT_CTX_OFF + ((size_t)((b * 2 + hk) * 64 + d)) * CTXL + pos; stride = CTXL; }
#pragma unroll
            for (int i = 0; i < 4; ++i) { vt[base + i * stride] = (bf16_t)(pk2(v0[i], 0.f) & 0xffffu); vt[base + (16 + i) * stride] = (bf16_t)(pk2(v1[i], 0.f) & 0xffffu); }
        }
        else if constexpr (R == 4 || R == 5) {
            f32x4 a, b;
#pragma unroll
            for (int i = 0; i < 4; ++i) { a[i] = gelu_tanh(v0[i]); b[i] = gelu_tanh(v1[i]); }
            if constexpr (R == 4) { bf16_t* o = (bf16_t*)(ws + WS_U) + (size_t)row * 512 + (c0 - 1280); st8bf_x(o, a, b, odd); }
            else {
                float ss = (a[0] * a[0] + a[1] * a[1]) + (a[2] * a[2] + a[3] * a[3]) + (b[0] * b[0] + b[1] * b[1]) + (b[2] * b[2] + b[3] * b[3]);
                ss += __shfl_xor(ss, 16); ss += __shfl_xor(ss, 32);
                if (((c0 >> 2) & 3) == 0) __hip_atomic_fetch_add((float*)(ws + WS_SSQ) + row, ss, __ATOMIC_RELAXED, __HIP_MEMORY_SCOPE_AGENT);
                bf16_t* o = (bf16_t*)(ws + WS_SV) + ((size_t)(row >> 7) * 512 + (c0 - 1792)) * 128 + (row & 127);
#pragma unroll
                for (int i = 0; i < 4; ++i) { o[i * 128] = (bf16_t)(pk2(a[i], 0.f) & 0xffffu); o[(16 + i) * 128] = (bf16_t)(pk2(b[i], 0.f) & 0xffffu); }
            }
        }
        else {
            f32x4 a, b;
#pragma unroll
            for (int i = 0; i < 4; ++i) { a[i] = sigmoidf_(v0[i]); b[i] = sigmoidf_(v1[i]); }
            const int cg = c0 - 2304;
            const size_t gi = ((((size_t)(row >> 8) * 24 + (cg >> 7)) * 8 + (((row >> 6) & 1) * 4 + ((cg >> 5) & 3))) * 64 + (((cg >> 2) & 3) * 16 + (row & 15))) * 64 + ((((row >> 7) & 1) * 4 + ((row >> 4) & 3)) * 8);
            u32x4 w; w.x = pk2(a[0], a[1]); w.y = pk2(a[2], a[3]); w.z = pk2(b[0], b[1]); w.w = pk2(b[2], b[3]);
            *(u32x4*)((bf16_t*)(ws + WS_GATES) + gi) = w;
        }
    }
    template <int BJ> __device__ __forceinline__ void sv_half_tile(const pg8::f32x4 (&acc)[2][2][4][2], int rowb, int c0) const {
#pragma unroll
        for (int ai = 0; ai < 2; ++ai) {
            f32x4 a[4], b[4];
#pragma unroll
            for (int m = 0; m < 4; ++m) {
                const int row = rowb + ai * 128 + m * 16;
#pragma unroll
                for (int i = 0; i < 4; ++i) { a[m][i] = gelu_tanh(acc[ai][BJ][m][0][i]); b[m][i] = gelu_tanh(acc[ai][BJ][m][1][i]); }
                float ss = (a[m][0] * a[m][0] + a[m][1] * a[m][1]) + (a[m][2] * a[m][2] + a[m][3] * a[m][3]) + (b[m][0] * b[m][0] + b[m][1] * b[m][1]) + (b[m][2] * b[m][2] + b[m][3] * b[m][3]);
                ss += __shfl_xor(ss, 16); ss += __shfl_xor(ss, 32);
                if (((c0 >> 2) & 3) == 0) __hip_atomic_fetch_add((float*)(ws + WS_SSQ) + row, ss, __ATOMIC_RELAXED, __HIP_MEMORY_SCOPE_AGENT);
            }
            const int row0 = rowb + ai * 128;
            bf16_t* o = (bf16_t*)(ws + WS_SV) + ((size_t)(row0 >> 7) * 512 + (c0 - 1792)) * 128 + (row0 & 64) + 4 * (row0 & 15);
#pragma unroll
            for (int i = 0; i < 4; ++i) {
                *(u32x2*)(o + i * 128) = (u32x2){pk2(a[0][i], a[1][i]), pk2(a[2][i], a[3][i])};
                *(u32x2*)(o + (16 + i) * 128) = (u32x2){pk2(b[0][i], b[1][i]), pk2(b[2][i], b[3][i])};
            }
            asm volatile("" ::: "memory");
        }
    }
    template <int R, int BJ> __device__ __forceinline__ void half_tile(const pg8::f32x4 (&acc)[2][2][4][2], int rowb, int c0) const {
        if constexpr (R == 5) { sv_half_tile<BJ>(acc, rowb, c0); return; }
#pragma unroll
        for (int ai = 0; ai < 2; ++ai)
#pragma unroll
            for (int m = 0; m < 4; ++m) { elem<R>(rowb + ai * 128 + m * 16, c0, acc[ai][BJ][m][0], acc[ai][BJ][m][1]); asm volatile("" ::: "memory"); }
    }
    template <int BJ> __device__ __forceinline__ void dispatch(const pg8::f32x4 (&acc)[2][2][4][2], int rowb, int cb, int c0) const {
        if (cb < 512) half_tile<0, BJ>(acc, rowb, c0);
        else if (cb < 1024) half_tile<1, BJ>(acc, rowb, c0);
        else if (cb < 1152) half_tile<2, BJ>(acc, rowb, c0);
        else if (cb < 1280) half_tile<3, BJ>(acc, rowb, c0);
        else if (cb < 1792) half_tile<4, BJ>(acc, rowb, c0);
        else if (cb < 2304) half_tile<5, BJ>(acc, rowb, c0);
        else half_tile<6, BJ>(acc, rowb, c0);
    }
    __device__ __forceinline__ void operator()(const pg8::f32x4 (&acc)[2][2][4][2], const pg8::Unit& u, int wr, int wc, int fr, int fq) const {
        const int rowb = u.pm * 256 + wr * 64 + fr + roff, cb0 = u.pn * 256 + coff, c00 = cb0 + wc * 32 + 4 * fq;
        dispatch<0>(acc, rowb, cb0, c00);
        dispatch<1>(acc, rowb, cb0 + 128, c00 + 128);
    }
};
struct E2F {
    unsigned char* ws; int pass;
    __device__ __forceinline__ void operator()(int row, int c0, f32x4 v0, f32x4 v1) const {
        const bf16_t* gates = (const bf16_t*)(ws + WS_GATES); float* yacc = (float*)(ws + WS_YACC); bf16_t* ym = (bf16_t*)(ws + WS_YM);
        const bf16_t* gp = gates + (size_t)row * 3072 + pass * 1024 + c0;
        const u32x2 g0 = *(const u32x2*)gp, g1 = *(const u32x2*)(gp + 16);
        f32x4 a, b;
        a[0] = bflo(g0.x) * v0[0]; a[1] = bfhi(g0.x) * v0[1]; a[2] = bflo(g0.y) * v0[2]; a[3] = bfhi(g0.y) * v0[3];
        b[0] = bflo(g1.x) * v1[0]; b[1] = bfhi(g1.x) * v1[1]; b[2] = bflo(g1.y) * v1[2]; b[3] = bfhi(g1.y) * v1[3];
        float* yp = yacc + (size_t)row * 1024 + c0;
        if (pass == 0) { *(f32x4*)yp = a; *(f32x4*)(yp + 16) = b; }
        else {
            a += *(const f32x4*)yp; b += *(const f32x4*)(yp + 16);
            if (pass == 1) { *(f32x4*)yp = a; *(f32x4*)(yp + 16) = b; }
            else { bf16_t* o = ym + (size_t)row * 1024 + c0; st4bf(o, a); st4bf(o + 16, b); }
        }
    }
};
struct E2H {
    unsigned char* ws;
    __device__ __forceinline__ void seg(const pg8::f32x4 (&acc)[2][4][2], pg8::f32x4 (&tot)[2][4][2], const pg8::Unit& u, int br, int wr, int wc, int fr, int fq) const {
        const bf16_t* gates = (const bf16_t*)(ws + WS_GATES); bf16_t* ym = (bf16_t*)(ws + WS_YM);
        const int c0 = u.pn * 128 + wc * 32 + 4 * fq;
#pragma unroll
        for (int ai = 0; ai < 2; ++ai)
#pragma unroll
            for (int m = 0; m < 4; ++m) {
                const int row = u.pm * 256 + ai * 128 + wr * 64 + m * 16 + fr;
                const size_t gi = ((((size_t)u.pm * 24 + (br * 8 + u.pn)) * 8 + (wr * 4 + wc)) * 64 + (fq * 16 + fr)) * 64 + (ai * 4 + m) * 8;
                const u32x4 gw4 = *(const u32x4*)(gates + gi);
                const u32x2 g0 = (u32x2){gw4.x, gw4.y}, g1 = (u32x2){gw4.z, gw4.w};
                const f32x4 v0 = acc[ai][m][0], v1 = acc[ai][m][1];
                f32x4 a, b;
                a[0] = bflo(g0.x) * v0[0]; a[1] = bfhi(g0.x) * v0[1]; a[2] = bflo(g0.y) * v0[2]; a[3] = bfhi(g0.y) * v0[3];
                b[0] = bflo(g1.x) * v1[0]; b[1] = bfhi(g1.x) * v1[1]; b[2] = bflo(g1.y) * v1[2]; b[3] = bfhi(g1.y) * v1[3];
                if (br == 0) { tot[ai][m][0] = a; tot[ai][m][1] = b; }
                else {
                    a += tot[ai][m][0]; b += tot[ai][m][1];
                    if (br == 1) { tot[ai][m][0] = a; tot[ai][m][1] = b; }
                    else { bf16_t* o = ym + (size_t)row * 1024 + c0; st8bf_x(o, a, b, fq & 1); }
                }
            }
    }
};
struct EResF {
    float* xl; unsigned char* ws; int moff;
    __device__ __forceinline__ void operator()(int row, int c0, f32x4 v0, f32x4 v1) const {
        float* xp; const float* mg; const float* modv = (const float*)(ws + WS_MODV) + moff; float* xc = (float*)(ws + WS_XC);
        if (row < ML) { xp = xl + (size_t)row * 1024; mg = modv + (row >> 11) * 6144; }
        else { xp = xc + (size_t)(row - ML) * 1024; mg = modv + 8 * 6144; }
        const f32x4 g0 = *(const f32x4*)(mg + c0), g1 = *(const f32x4*)(mg + c0 + 16);
        const f32x4 a = *(const f32x4*)(xp + c0), b = *(const f32x4*)(xp + c0 + 16);
        *(f32x4*)(xp + c0) = a + g0 * v0; *(f32x4*)(xp + c0 + 16) = b + g1 * v1;
    }
};
struct TailOrder {
    pg8::StaticOrder lat; int G, c, nlat, nctx_tiles, NS, ktiles;
    __device__ __forceinline__ void init(int K, int G_, int c_, bool with_ctx) {
        lat.init(ML, DM, G_, c_); G = G_; c = c_; nlat = (lat.nwg - c_ + G_ - 1) / G_; if (nlat < 0) nlat = 0;
        nctx_tiles = with_ctx ? (MC / 256) * (DM / 256) : 0; ktiles = K / 64; NS = (ktiles == 16) ? 4 : 6;
    }
    __device__ __forceinline__ bool next(int i, pg8::Unit& u) const {
        const bool has_sub = c < nctx_tiles * NS; const int il = has_sub ? 1 : 0;
        pg8::Unit a; const bool okl = lat.next(0, a);
        const int j = c; const int tile = j / NS, sp = j - tile * NS;
        int kt0, n;
        if (ktiles == 16) { kt0 = sp * 4; n = 4; } else { n = sp < 4 ? 8 : 6; kt0 = sp < 4 ? sp * 8 : 32 + (sp - 4) * 6; }
        const bool isl = (i == il);
        u.pm = isl ? a.pm : ML / 256 + (tile >> 2); u.pn = isl ? a.pn : (tile & 3); u.k0b = isl ? 0 : kt0 * 128; u.nt = isl ? 0 : n;
        return isl ? okl : (i < il);
    }
    __device__ __forceinline__ void a_ready(const pg8::Unit&) const {}
    __device__ __forceinline__ void done(const pg8::Unit&) const {}
};
struct EpiRes {
    static constexpr bool PERM = false, AFTER_DRAIN = false;
    float* xl; const float* xsl; const float* xsc; unsigned char* ws; int moff;
    __device__ __forceinline__ void operator()(const pg8::f32x4 (&acc)[2][2][4][2], const pg8::Unit& u, int wr, int wc, int fr, int fq) const {
        const float* modv = (const float*)(ws + WS_MODV) + moff; float* xc = (float*)(ws + WS_XC);
        const bool part = u.nt != 0;
        const int sp = (u.nt == 4) ? (u.k0b >> 9) : (u.k0b < 4096 ? (u.k0b >> 10) : 4 + (u.k0b - 4096) / 768);
        const int row0 = u.pm * 256 + wr * 64 + fr, c0 = u.pn * 256 + wc * 32 + 4 * fq;
        const float* mg = modv + (row0 < ML ? (row0 >> 11) : 8) * 6144 + c0;
        f32x4 gt[2][2];
#pragma unroll
        for (int bj = 0; bj < 2; ++bj) { gt[bj][0] = *(const f32x4*)(mg + bj * 128); gt[bj][1] = *(const f32x4*)(mg + bj * 128 + 16); }
        if (!part) {
            float* xp = xl + (size_t)row0 * 1024 + c0; const float* xq = xsl + (size_t)row0 * 1024 + c0;
#pragma unroll
            for (int ai = 0; ai < 2; ++ai) {
                f32x4 xv[4][2][2];
#pragma unroll
                for (int m = 0; m < 4; ++m)
#pragma unroll
                    for (int bj = 0; bj < 2; ++bj) { const float* q = xq + (size_t)(ai * 128 + m * 16) * 1024 + bj * 128; xv[m][bj][0] = *(const f32x4*)q; xv[m][bj][1] = *(const f32x4*)(q + 16); }
#pragma unroll
                for (int m = 0; m < 4; ++m)
#pragma unroll
                    for (int bj = 0; bj < 2; ++bj) { float* o = xp + (size_t)(ai * 128 + m * 16) * 1024 + bj * 128;
                        *(f32x4*)o = xv[m][bj][0] + gt[bj][0] * acc[ai][bj][m][0]; *(f32x4*)(o + 16) = xv[m][bj][1] + gt[bj][1] * acc[ai][bj][m][1]; }
                asm volatile("" ::: "memory");
            }
        } else {
            float* sl = (float*)(ws + WS_SLAB) + ((size_t)sp * MC + (row0 - ML)) * 1024 + c0;
#pragma unroll
            for (int ai = 0; ai < 2; ++ai)
#pragma unroll
                for (int m = 0; m < 4; ++m)
#pragma unroll
                    for (int bj = 0; bj < 2; ++bj) { float* o = sl + (size_t)(ai * 128 + m * 16) * 1024 + bj * 128;
                        *(f32x4*)o = gt[bj][0] * acc[ai][bj][m][0]; *(f32x4*)(o + 16) = gt[bj][1] * acc[ai][bj][m][1]; }
        }
    }
};
struct EpiResNorm {
    static constexpr bool PERM = false, AFTER_DRAIN = true;
    float* xl; const float* xsl; unsigned char* ws; int moff;
    const float* ngain; int noff; float* fout; unsigned* cnt;
    __device__ __forceinline__ void operator()(const pg8::f32x4 (&acc)[2][2][4][2], const pg8::Unit& u, int wr, int wc, int fr, int fq) const {
        const float* modv = (const float*)(ws + WS_MODV) + moff;
        const int sp = (u.nt == 4) ? (u.k0b >> 9) : (u.k0b < 4096 ? (u.k0b >> 10) : 4 + (u.k0b - 4096) / 768);
        const int row0 = u.pm * 256 + wr * 64 + fr, c0 = u.pn * 256 + wc * 32 + 4 * fq;
        const float* mg = modv + 8 * 6144 + c0;
        f32x4 gt[2][2];
#pragma unroll
        for (int bj = 0; bj < 2; ++bj) { gt[bj][0] = *(const f32x4*)(mg + bj * 128); gt[bj][1] = *(const f32x4*)(mg + bj * 128 + 16); }
        float* sl = (float*)(ws + WS_SLAB) + ((size_t)sp * MC + (row0 - ML)) * 1024 + c0;
#pragma unroll
        for (int ai = 0; ai < 2; ++ai)
#pragma unroll
            for (int m = 0; m < 4; ++m)
#pragma unroll
                for (int bj = 0; bj < 2; ++bj) { float* o = sl + (size_t)(ai * 128 + m * 16) * 1024 + bj * 128;
                    *(f32x4*)o = gt[bj][0] * acc[ai][bj][m][0]; *(f32x4*)(o + 16) = gt[bj][1] * acc[ai][bj][m][1]; }
    }
    __device__ __forceinline__ void fused(pg8::f32x4 (&acc)[2][2][4][2], const pg8::Unit& u, int wr, int wc, int fr, int fq, LAS unsigned char* lds, int wid, int lane) const {
        const float* modv = (const float*)(ws + WS_MODV);
        const int row0 = u.pm * 256 + wr * 64 + fr, c0 = u.pn * 256 + wc * 32 + 4 * fq, bidx = row0 >> 11;
        const bool final_ = noff < 0;
        {
            const float* mg = modv + moff + bidx * 6144 + c0;
            f32x4 gt[2][2];
#pragma unroll
            for (int bj = 0; bj < 2; ++bj) { gt[bj][0] = *(const f32x4*)(mg + bj * 128); gt[bj][1] = *(const f32x4*)(mg + bj * 128 + 16); }
            float* xf = xl + ((size_t)(u.pm * 4 + u.pn) * 32 * 512 + (size_t)(wid * 64 + lane)) * 4;
            const float* xq = xsl ? xsl + (size_t)row0 * 1024 + c0 : nullptr;
#pragma unroll
            for (int ai = 0; ai < 2; ++ai) {
                f32x4 xv[4][2][2];
                if (xq) {
#pragma unroll
                    for (int m = 0; m < 4; ++m)
#pragma unroll
                        for (int bj = 0; bj < 2; ++bj) { const float* q = xq + (size_t)(ai * 128 + m * 16) * 1024 + bj * 128; xv[m][bj][0] = *(const f32x4*)q; xv[m][bj][1] = *(const f32x4*)(q + 16); }
                } else {
#pragma unroll
                    for (int m = 0; m < 4; ++m)
#pragma unroll
                        for (int bj = 0; bj < 2; ++bj) { const float* q = xf + (size_t)((ai * 16 + m * 4 + bj * 2) * 512) * 4; xv[m][bj][0] = *(const f32x4*)q; xv[m][bj][1] = *(const f32x4*)(q + 512 * 4); }
                }
#pragma unroll
                for (int m = 0; m < 4; ++m)
#pragma unroll
                    for (int bj = 0; bj < 2; ++bj) { float* o = xf + (size_t)((ai * 16 + m * 4 + bj * 2) * 512) * 4;
                        acc[ai][bj][m][0] = xv[m][bj][0] + gt[bj][0] * acc[ai][bj][m][0]; acc[ai][bj][m][1] = xv[m][bj][1] + gt[bj][1] * acc[ai][bj][m][1];
                        if (!final_) { *(f32x4*)o = acc[ai][bj][m][0]; *(f32x4*)(o + 512 * 4) = acc[ai][bj][m][1]; } }
                asm volatile("" ::: "memory");
            }
        }
        LAS float* P = (LAS float*)(lds + LDSCTL_OFF + 1024);
        LAS float* S = P + 1024;
        float* slot = (float*)(ws + WS_XSLOT); unsigned* cn = cnt + 64 * u.pm;
#pragma unroll
        for (int ai = 0; ai < 2; ++ai)
#pragma unroll
            for (int m = 0; m < 4; ++m) {
                float s = 0.f;
#pragma unroll
                for (int bj = 0; bj < 2; ++bj)
#pragma unroll
                    for (int n = 0; n < 2; ++n) { const f32x4 x = acc[ai][bj][m][n]; s += (x[0] * x[0] + x[1] * x[1]) + (x[2] * x[2] + x[3] * x[3]); }
                s += __shfl_xor(s, 16); s += __shfl_xor(s, 32);
                if (fq == 0) P[(ai * 128 + wr * 64 + m * 16 + fr) * 4 + wc] = s;
            }
        asm volatile("s_waitcnt lgkmcnt(0)" ::: "memory"); __builtin_amdgcn_s_barrier(); asm volatile("" ::: "memory");
        const int prow = wid * 32 + (lane & 31);
        if (lane < 32) {
            const float tot = (P[prow * 4 + 0] + P[prow * 4 + 1]) + (P[prow * 4 + 2] + P[prow * 4 + 3]);
            __hip_atomic_store((unsigned*)slot + ((size_t)(u.pm * 256 + prow) * 4 + u.pn), __float_as_uint(tot), __ATOMIC_RELAXED, __HIP_MEMORY_SCOPE_AGENT);
        }
        asm volatile("s_waitcnt vmcnt(0)" ::: "memory");
        if (lane == 0) __hip_atomic_fetch_add(cn, 1u, __ATOMIC_RELAXED, __HIP_MEMORY_SCOPE_AGENT);
        if (wid == 0) {
            unsigned sp_ = 0;
            while ((unsigned)__builtin_amdgcn_readfirstlane(__hip_atomic_load(cn, __ATOMIC_RELAXED, __HIP_MEMORY_SCOPE_AGENT)) < 32u) { __builtin_amdgcn_s_sleep(2); if (++sp_ > (1u << 22)) break; }
            __builtin_amdgcn_fence(__ATOMIC_ACQUIRE, "agent");
        }
        asm volatile("s_waitcnt vmcnt(0) lgkmcnt(0)" ::: "memory"); __builtin_amdgcn_s_barrier(); asm volatile("" ::: "memory");
        if (lane < 32) {
            const unsigned* sr = (const unsigned*)slot + (size_t)(u.pm * 256 + prow) * 4;
            float q = 0.f;
#pragma unroll
            for (int t = 0; t < 4; ++t) q += __uint_as_float(__hip_atomic_load(sr + t, __ATOMIC_RELAXED, __HIP_MEMORY_SCOPE_AGENT));
            S[prow] = 1.f / sqrtf(q * (1.f / 1024.f) + NORM_EPS);
        }
        asm volatile("s_waitcnt lgkmcnt(0)" ::: "memory"); __builtin_amdgcn_s_barrier(); asm volatile("" ::: "memory");
        bf16_t* hp = (bf16_t*)(ws + WS_H) + (size_t)row0 * 1024 + c0; float* fo = fout + (size_t)row0 * 1024 + c0;
#pragma unroll
        for (int bj = 0; bj < 2; ++bj) {
            f32x4 mul[2], sh[2];
#pragma unroll
            for (int n = 0; n < 2; ++n) {
                const int c = c0 + bj * 128 + n * 16;
                mul[n] = *(const f32x4*)(ngain + c); sh[n] = (f32x4){0.f, 0.f, 0.f, 0.f};
                if (!final_) { const float* mv = modv + noff + bidx * 6144 + c; sh[n] = *(const f32x4*)mv; mul[n] = mul[n] * (*(const f32x4*)(mv + 1024) + 1.f); }
            }
#pragma unroll
            for (int ai = 0; ai < 2; ++ai)
#pragma unroll
                for (int m = 0; m < 4; ++m) {
                    const float rs = S[ai * 128 + wr * 64 + m * 16 + fr];
                    const f32x4 y0 = (acc[ai][bj][m][0] * rs) * mul[0] + sh[0], y1 = (acc[ai][bj][m][1] * rs) * mul[1] + sh[1];
                    const size_t off = (size_t)(ai * 128 + m * 16) * 1024 + bj * 128;
                    if (!final_) { st8bf_x(hp + off, y0, y1, fq & 1); }
                    else { *(f32x4*)(fo + off) = y0; *(f32x4*)(fo + off + 16) = y1; }
                }
        }
    }
};
struct EpiE4 {
    static constexpr bool PERM = false, AFTER_DRAIN = false;
    unsigned char* ws;
    __device__ __forceinline__ void operator()(const pg8::f32x4 (&acc)[2][2][4][2], const pg8::Unit& u, int wr, int wc, int fr, int fq) const {
        bf16_t* act = (bf16_t*)(ws + WS_ACT);
        const int c0 = u.pn * 256 + wc * 32 + 4 * fq, oc = ((c0 >> 5) << 4) + (c0 & 15);
        const bool odd = fq & 1;
#pragma unroll
        for (int ai = 0; ai < 2; ++ai)
#pragma unroll
            for (int m = 0; m < 4; ++m) {
                const int row = u.pm * 256 + ai * 128 + wr * 64 + m * 16 + fr;
                f32x4 a, b;
#pragma unroll
                for (int i = 0; i < 4; ++i) { a[i] = siluf_(acc[ai][0][m][0][i]) * acc[ai][0][m][1][i]; b[i] = siluf_(acc[ai][1][m][0][i]) * acc[ai][1][m][1][i]; }
                unsigned a0 = pk2(a[0], a[1]), a1 = pk2(a[2], a[3]), b0 = pk2(b[0], b[1]), b1 = pk2(b[2], b[3]);
                auto r0 = __builtin_amdgcn_permlane16_swap(a0, b0, false, false); a0 = r0[0]; b0 = r0[1];
                auto r1 = __builtin_amdgcn_permlane16_swap(a1, b1, false, false); a1 = r1[0]; b1 = r1[1];
                *(u32x4*)(act + (size_t)row * D_FF + oc + (odd ? 60 : 0)) = (u32x4){a0, a1, b0, b1};
                asm volatile("" ::: "memory");
            }
    }
};
struct E4F {
    unsigned char* ws;
    __device__ __forceinline__ void operator()(int row, int c0, f32x4 v0, f32x4 v1) const {
        bf16_t* act = (bf16_t*)(ws + WS_ACT); f32x4 a;
#pragma unroll
        for (int i = 0; i < 4; ++i) a[i] = siluf_(v0[i]) * v1[i];
        st4bf(act + (size_t)row * D_FF + ((c0 >> 5) << 4) + (c0 & 15), a);
    }
};

template <int MODE> __device__ __forceinline__ void transpose_item(const float* W, int K, int N, bf16_t* WT, LAS float* scr, int item, int lane) {
    const int nblk = N / 32, kb = item / nblk, nb = item % nblk, k0 = 64 * kb, n0 = 32 * nb;
    float wv[32];
#pragma unroll
    for (int i = 0; i < 32; ++i) wv[i] = W[(size_t)(k0 + 2 * i + (lane >> 5)) * N + n0 + (lane & 31)];
#pragma unroll
    for (int i = 0; i < 32; ++i) scr[(2 * i + (lane >> 5)) * 33 + (lane & 31)] = wv[i];
    asm volatile("s_waitcnt lgkmcnt(0)" ::: "memory");
    const int c = lane & 7;
#pragma unroll
    for (int j = 0; j < 4; ++j) { const int n = (lane >> 3) + 8 * j; const LAS float* s = scr + (8 * c) * 33 + n;
        u32x4 o; o.x = pk2(s[0 * 33], s[1 * 33]); o.y = pk2(s[2 * 33], s[3 * 33]); o.z = pk2(s[4 * 33], s[5 * 33]); o.w = pk2(s[6 * 33], s[7 * 33]);
        int drow = n0 + n;
        if (MODE == 1) { const int up = (n0 >= D_FF) ? 16 : 0; const int mm = (n0 >= D_FF ? n0 - D_FF : n0) + n; drow = ((mm >> 4) << 5) + up + (mm & 15); }
        *(u32x4*)(WT + (size_t)drow * K + k0 + 8 * c) = o; }
    asm volatile("s_waitcnt lgkmcnt(0)" ::: "memory");
}

__device__ __forceinline__ void norm_load(f32x4 (&v)[4], const float* xrow, int lane, const float* slab, int npend) {
    const f32x4* xr = (const f32x4*)xrow + lane;
#pragma unroll
    for (int j = 0; j < 4; ++j) v[j] = xr[64 * j];
    if (npend) {
        for (int sp = 0; sp < npend; ++sp) { const f32x4* pr = (const f32x4*)(slab + (size_t)sp * MC * 1024) + lane;
#pragma unroll
            for (int j = 0; j < 4; ++j) v[j] += pr[64 * j]; }
    }
}
__device__ __forceinline__ void norm_finish(const f32x4 (&v)[4], float* xdst, int npend, const float* gain, const float* shift, const float* scale, bf16_t* orow, int lane) {
    float s = 0.f;
    if (npend) { f32x4* xw = (f32x4*)xdst + lane;
#pragma unroll
        for (int j = 0; j < 4; ++j) xw[64 * j] = v[j]; }
#pragma unroll
    for (int j = 0; j < 4; ++j) s += (v[j][0] * v[j][0] + v[j][1] * v[j][1]) + (v[j][2] * v[j][2] + v[j][3] * v[j][3]);
    const float rstd = 1.f / sqrtf(wave_sum(s) * (1.f / DM) + NORM_EPS);
#pragma unroll
    for (int j = 0; j < 4; ++j) {
        const int c = 4 * lane + 256 * j;
        const f32x4 g = *(const f32x4*)(gain + c), sh = *(const f32x4*)(shift + c), sc = *(const f32x4*)(scale + c);
        f32x4 y = (v[j] * rstd) * g; y = y * (sc + 1.f) + sh;
        st4bf(orow + c, y);
    }
}

constexpr int ATT_KB = 128 * 144, ATT_VB = 64 * 264, ATT_BUF = ATT_KB + ATT_VB;
__device__ __forceinline__ void attn_unit(int unit, LAS unsigned char* lds, const bf16_t* Q, const bf16_t* KB, const bf16_t* VT, bf16_t* Y, const float* sink_l, const int tid) {
    const int lane = tid & 63, wid = __builtin_amdgcn_readfirstlane(tid >> 6), q32 = lane & 31, h = lane >> 5;
    const bool is_ctx = unit >= 256;
    int b, hk, nb; long qrow0;
    if (!is_ctx) { b = unit >> 5; hk = (unit >> 4) & 1; nb = unit & 15; qrow0 = (long)b * SEQ + nb * 128; }
    else { const int u2 = unit - 256; b = u2 >> 2; hk = (u2 >> 1) & 1; nb = u2 & 1; qrow0 = (long)ML + b * CTXL + nb * 128; }
    const int hq = hk * 4 + (wid >> 1);
    const int qpos0 = nb * 128 + (wid & 1) * 64;
    const long qr = qrow0 + (wid & 1) * 64;
    bf16x8 qf[2][4];
#pragma unroll
    for (int qb = 0; qb < 2; ++qb)
#pragma unroll
        for (int s = 0; s < 4; ++s) qf[qb][s] = *(const bf16x8*)(Q + (size_t)(qr + qb * 32 + q32) * 512 + hq * 64 + s * 16 + h * 8);
    const float sink2 = sink_l[hq] * LOG2E;
    float mrun[2] = {sink2, sink2}; float lrun[2]; lrun[0] = lrun[1] = (h == 0) ? 1.f : 0.f;
    f32x16 o[2][2];
#pragma unroll
    for (int a = 0; a < 2; ++a)
#pragma unroll
        for (int d = 0; d < 2; ++d)
#pragma unroll
            for (int r = 0; r < 16; ++r) o[a][d][r] = 0.f;
    int c_lo = 0, nlc = 0;
    if (!is_ctx) { c_lo = nb > 0 ? nb - 1 : 0; const int c_hi = nb < 15 ? nb + 1 : 15; nlc = c_hi - c_lo + 1; }
    const int nch = nlc + 2;
    const int kkey = tid >> 3, kpart = tid & 7, vd = tid >> 4, vpart = tid & 15;
    const bf16_t* kg_l = KB + (size_t)((long)b * SEQ + kkey) * 128 + hk * 64 + kpart * 8;
    const bf16_t* kg_c = KB + (size_t)((long)ML + b * CTXL + kkey) * 128 + hk * 64 + kpart * 8;
    const bf16_t* vg_l = VT + ((size_t)((b * 2 + hk) * 64 + vd)) * SEQ + vpart * 8;
    const bf16_t* vg_c = VT + VT_CTX_OFF + ((size_t)((b * 2 + hk) * 64 + vd)) * CTXL + vpart * 8;
    const int klds = kkey * 144 + kpart * 16, vlds = ATT_KB + vd * 264 + vpart * 16;
    u32x4 kreg[2], vreg[2];
#define ATT_GLOAD(ci) do { const bool loc_ = (ci) < nlc; const int key0_ = loc_ ? (c_lo + (ci)) * 128 : ((ci) - nlc) * 128; \
        const bf16_t* kq_ = (loc_ ? kg_l : kg_c) + (size_t)key0_ * 128; const bf16_t* vq_ = (loc_ ? vg_l : vg_c) + key0_; const size_t vs_ = loc_ ? SEQ : CTXL; \
        kreg[0] = *(const u32x4*)kq_; kreg[1] = *(const u32x4*)(kq_ + 64 * 128); vreg[0] = *(const u32x4*)vq_; vreg[1] = *(const u32x4*)(vq_ + 32 * vs_); } while (0)
#define ATT_LWRITE(buf) do { LAS unsigned char* bb_ = lds + (buf) * ATT_BUF; \
        *(LAS u32x4*)(bb_ + klds) = kreg[0]; *(LAS u32x4*)(bb_ + klds + 64 * 144) = kreg[1]; \
        *(LAS u32x2*)(bb_ + vlds) = (u32x2){vreg[0].x, vreg[0].y}; *(LAS u32x2*)(bb_ + vlds + 8) = (u32x2){vreg[0].z, vreg[0].w}; \
        *(LAS u32x2*)(bb_ + vlds + 32 * 264) = (u32x2){vreg[1].x, vreg[1].y}; *(LAS u32x2*)(bb_ + vlds + 32 * 264 + 8) = (u32x2){vreg[1].z, vreg[1].w}; } while (0)
    ATT_GLOAD(0); ATT_LWRITE(0);
    __syncthreads();
    for (int ci = 0; ci < nch; ++ci) {
        if (ci + 1 < nch) ATT_GLOAD(ci + 1);
        const bool local = ci < nlc; const int key0 = local ? (c_lo + ci) * 128 : 0;
        const LAS unsigned char* kb_ = lds + (ci & 1) * ATT_BUF; const LAS unsigned char* vb_ = kb_ + ATT_KB;
        for (int tt = 0; tt < 4; ++tt) {
            const int kpos = key0 + tt * 32;
            if (local && (kpos + 31 < qpos0 - 128 || kpos > qpos0 + 63 + 128)) continue;
            bf16x8 kf[4], vf[2][2];
#pragma unroll
            for (int s = 0; s < 4; ++s) kf[s] = *(const LAS bf16x8*)(kb_ + (tt * 32 + q32) * 144 + s * 32 + h * 16);
#pragma unroll
            for (int db = 0; db < 2; ++db)
#pragma unroll
                for (int s = 0; s < 2; ++s) {
                    const LAS unsigned char* pv = vb_ + (db * 32 + q32) * 264 + (tt * 32 + s * 16 + h * 4) * 2;
                    const s16x4 lo = *(const LAS s16x4*)pv, hi = *(const LAS s16x4*)(pv + 16);
                    vf[db][s] = (bf16x8){lo[0], lo[1], lo[2], lo[3], hi[0], hi[1], hi[2], hi[3]};
                }
#pragma unroll
            for (int qb = 0; qb < 2; ++qb) {
                bool needmask = false;
                if (local) { const int dq = kpos - (qpos0 + qb * 32); if (dq > 128 || dq < -128) continue; needmask = (dq == 128 || dq == -128); }
                f32x16 sa; const float nm = -mrun[qb];
#pragma unroll
                for (int r = 0; r < 16; ++r) sa[r] = nm;
#pragma unroll
                for (int s = 0; s < 4; ++s) sa = __builtin_amdgcn_mfma_f32_32x32x16_bf16(kf[s], qf[qb][s], sa, 0, 0, 0);
                if (needmask) {
                    const int qpos = qpos0 + qb * 32 + q32;
#pragma unroll
                    for (int r = 0; r < 16; ++r) { const int key = kpos + (r & 3) + 8 * (r >> 2) + 4 * h; const int dd = qpos - key; if (dd > 128 || dd < -128) sa[r] = -INFINITY; }
                }
                float tm = fmaxf(fmaxf(sa[0], sa[1]), sa[2]);
#pragma unroll
                for (int r = 3; r < 15; r += 2) tm = fmaxf(fmaxf(tm, sa[r]), sa[r + 1]);
                tm = fmaxf(tm, sa[15]);
                { const auto rr = __builtin_amdgcn_permlane32_swap(__float_as_uint(tm), __float_as_uint(tm), false, false); tm = fmaxf(__uint_as_float(rr[0]), __uint_as_float(rr[1])); }
                if (__builtin_amdgcn_ballot_w64(tm > 8.f) != 0ull) {
                    const float dl = fmaxf(tm, 0.f); mrun[qb] += dl;
                    const float f = fast_exp2(-dl); lrun[qb] *= f;
#pragma unroll
                    for (int r = 0; r < 16; ++r) sa[r] -= dl;
#pragma unroll
                    for (int db = 0; db < 2; ++db)
#pragma unroll
                        for (int r = 0; r < 16; ++r) o[qb][db][r] *= f;
                }
                float ps0 = 0.f, ps1 = 0.f;
#pragma unroll
                for (int r = 0; r < 16; r += 2) { sa[r] = fast_exp2(sa[r]); sa[r + 1] = fast_exp2(sa[r + 1]); ps0 += sa[r]; ps1 += sa[r + 1]; }
                lrun[qb] += ps0 + ps1;
                bf16x8 pf[2];
#pragma unroll
                for (int s = 0; s < 2; ++s) {
                    u32x4 w; w.x = pk2(sa[8 * s + 0], sa[8 * s + 1]); w.y = pk2(sa[8 * s + 2], sa[8 * s + 3]); w.z = pk2(sa[8 * s + 4], sa[8 * s + 5]); w.w = pk2(sa[8 * s + 6], sa[8 * s + 7]);
                    pf[s] = __builtin_bit_cast(bf16x8, w);
                }
#pragma unroll
                for (int db = 0; db < 2; ++db)
#pragma unroll
                    for (int s = 0; s < 2; ++s) o[qb][db] = __builtin_amdgcn_mfma_f32_32x32x16_bf16(vf[db][s], pf[s], o[qb][db], 0, 0, 0);
            }
        }
        if (ci + 1 < nch) ATT_LWRITE((ci + 1) & 1);
        __syncthreads();
    }
#undef ATT_GLOAD
#undef ATT_LWRITE
#pragma unroll
    for (int qb = 0; qb < 2; ++qb) {
        const float lt = lrun[qb] + __shfl_xor(lrun[qb], 32); const float inv = 1.f / lt;
        bf16_t* yr = Y + (size_t)(qr + qb * 32 + q32) * 512 + hq * 64;
#pragma unroll
        for (int db = 0; db < 2; ++db)
#pragma unroll
            for (int r4 = 0; r4 < 4; r4 += 2) {
                unsigned a0 = pk2(o[qb][db][4 * r4] * inv, o[qb][db][4 * r4 + 1] * inv), a1 = pk2(o[qb][db][4 * r4 + 2] * inv, o[qb][db][4 * r4 + 3] * inv);
                unsigned b0 = pk2(o[qb][db][4 * r4 + 4] * inv, o[qb][db][4 * r4 + 5] * inv), b1 = pk2(o[qb][db][4 * r4 + 6] * inv, o[qb][db][4 * r4 + 7] * inv);
                const auto s0 = __builtin_amdgcn_permlane32_swap(a0, b0, false, false); a0 = s0[0]; b0 = s0[1];
                const auto s1 = __builtin_amdgcn_permlane32_swap(a1, b1, false, false); a1 = s1[0]; b1 = s1[1];
                *(u32x4*)(yr + db * 32 + r4 * 8 + h * 8) = (u32x4){a0, a1, b0, b1};
            }
    }
}

__device__ __forceinline__ void sg_unit(int unit, LAS unsigned char* lds, const bf16_t* SVT, const float* SSQ, const bf16_t* U, bf16_t* YS, const bf16_t* WSP, const float* gain_l, const float* bsp_l, const int tid) {
    const int lane = tid & 63, wid = __builtin_amdgcn_readfirstlane(tid >> 6), fr = lane & 15, fq = lane >> 4;
    const int ci = unit >> 2, g = unit & 3; const long row0 = (long)ci * 128;
    LAS float* rstd = (LAS float*)lds;
    LAS unsigned char* Wp = lds + 512;
    bf16x8 af[4];
#pragma unroll
    for (int ks = 0; ks < 4; ++ks) af[ks] = *(const bf16x8*)(SVT + ((size_t)ci * 512 + g * 128 + 16 * wid + fr) * 128 + ks * 32 + fq * 8);
    u32x2 uw8[8]; float bs8[8];
#pragma unroll
    for (int pt = 0; pt < 8; ++pt) { const int pp = pt * 16 + fr; bs8[pt] = bsp_l[g * 128 + pp]; uw8[pt] = *(const u32x2*)(U + (size_t)(row0 + pp) * 512 + g * 128 + 16 * wid + 4 * fq); }
    if (tid < 128) { const int r = (tid & 64) + 16 * (tid & 3) + ((tid & 63) >> 2);
        rstd[tid] = 1.f / sqrtf(SSQ[row0 + r] * (1.f / 512.f) + NORM_EPS); }
    __syncthreads();
#pragma unroll
    for (int it = 0; it < 4; ++it) {
        const int idx = tid + it * NTHR, pp = idx >> 4, part = idx & 15;
        const u32x4 w = *(const u32x4*)(WSP + (size_t)(g * 128 + pp) * 128 + part * 8);
        const f32x4 r0 = *(const LAS f32x4*)(rstd + part * 8), r1 = *(const LAS f32x4*)(rstd + part * 8 + 4);
        u32x4 o;
        o.x = pk2(bflo(w.x) * r0[0], bfhi(w.x) * r0[1]); o.y = pk2(bflo(w.y) * r0[2], bfhi(w.y) * r0[3]);
        o.z = pk2(bflo(w.z) * r1[0], bfhi(w.z) * r1[1]); o.w = pk2(bflo(w.w) * r1[2], bfhi(w.w) * r1[3]);
        *(LAS u32x4*)(Wp + pp * 272 + part * 16) = o;
    }
    __syncthreads();
    f32x4 acc[8];
#pragma unroll
    for (int pt = 0; pt < 8; ++pt) acc[pt] = (f32x4){0.f, 0.f, 0.f, 0.f};
#pragma unroll
    for (int ks = 0; ks < 4; ++ks)
#pragma unroll
        for (int pt = 0; pt < 8; ++pt) {
            const bf16x8 bfr = *(const LAS bf16x8*)(Wp + (pt * 16 + fr) * 272 + (ks * 32 + fq * 8) * 2);
            acc[pt] = __builtin_amdgcn_mfma_f32_16x16x32_bf16(af[ks], bfr, acc[pt], 0, 0, 0);
        }
    const f32x4 gn = *(const f32x4*)(gain_l + g * 128 + 16 * wid + 4 * fq);
    const bool odd = fq & 1;
#pragma unroll
    for (int pt = 0; pt < 8; pt += 2) {
        unsigned w[2][2];
#pragma unroll
        for (int e = 0; e < 2; ++e) {
            const f32x4 a = acc[pt + e]; const u32x2 uw = uw8[pt + e]; const float bias = bs8[pt + e];
            w[e][0] = pk2(bflo(uw.x) * (a[0] * gn[0] + bias), bfhi(uw.x) * (a[1] * gn[1] + bias));
            w[e][1] = pk2(bflo(uw.y) * (a[2] * gn[2] + bias), bfhi(uw.y) * (a[3] * gn[3] + bias));
        }
        const auto r0 = __builtin_amdgcn_permlane16_swap(w[0][0], w[1][0], false, false); const auto r1 = __builtin_amdgcn_permlane16_swap(w[0][1], w[1][1], false, false);
        const size_t so = (size_t)(row0 + (pt + (odd ? 1 : 0)) * 16 + fr) * 512 + g * 128 + 16 * wid + 4 * (fq & ~1);
        *(u32x4*)(YS + so) = (u32x4){r0[0], r1[0], r0[1], r1[1]};
    }
    __syncthreads();
}

template <int GI> __device__ __forceinline__ void pool_pass(unsigned char* ws, int Mrows, long gtid, long NGT) {
    constexpr int HALFW = 1 << GI, R = 4, NW = R + 2 * HALFW - 1;
    const bf16_t* ZP = (const bf16_t*)(ws + WS_ZPOOL); bf16_t* PO = (bf16_t*)(ws + WS_POOLED);
    for (long t = gtid; t < (long)(Mrows / R) * 16; t += NGT) {
        const int row0 = (int)(t >> 4) * R, ch = GI * 16 + ((int)t & 15);
        int s0, L; if (row0 < ML) { s0 = row0 & ~(SEQ - 1); L = SEQ; } else { s0 = ML + ((row0 - ML) & ~(CTXL - 1)); L = CTXL; }
        const int pos0 = row0 - s0;
        u32x4 w[NW];
#pragma unroll
        for (int j = 0; j < NW; ++j) { const int pj = pos0 + j - HALFW; const int pc = pj < 0 ? 0 : (pj >= L ? L - 1 : pj); w[j] = *(const u32x4*)(ZP + (size_t)(s0 + pc) * 512 + ch * 8); }
        float a[8];
#pragma unroll
        for (int i = 0; i < 8; ++i) a[i] = 0.f;
#pragma unroll
        for (int j = 0; j < 2 * HALFW; ++j) { const int pj = pos0 + j - HALFW; const float msk = (pj >= 0 && pj < L) ? 1.f : 0.f;
#pragma unroll
            for (int k = 0; k < 4; ++k) { a[2 * k] += msk * bflo(w[j][k]); a[2 * k + 1] += msk * bfhi(w[j][k]); } }
#pragma unroll
        for (int r = 0; r < R; ++r) {
            const int pos = pos0 + r; const int lo = max(pos - HALFW, 0), hi = min(pos + HALFW, L);
            const float ic = 1.f / (float)(hi - lo);
            const u32x4 sw = w[r + HALFW];
            u32x4 o;
#pragma unroll
            for (int k = 0; k < 4; ++k) o[k] = pk2(a[2 * k] * ic - bflo(sw[k]), a[2 * k + 1] * ic - bfhi(sw[k]));
            *(u32x4*)(PO + (size_t)(row0 + r) * 512 + ch * 8) = o;
            if (r + 1 < R) {
                const int pe = pos0 + r + HALFW, pl = pos0 + r - HALFW; const float me = (pe < L) ? 1.f : 0.f, ml = (pl >= 0) ? 1.f : 0.f;
#pragma unroll
                for (int k = 0; k < 4; ++k) { a[2 * k] += me * bflo(w[r + 2 * HALFW][k]) - ml * bflo(w[r][k]); a[2 * k + 1] += me * bfhi(w[r + 2 * HALFW][k]) - ml * bfhi(w[r][k]); }
            }
        }
    }
}

#ifndef REPMASK
#define REPMASK 0
#endif
#ifndef PHMASK
#define PHMASK 0xffff
#endif
constexpr int NPH = 1 + 8 * DEPTH + 1;

__global__ void __launch_bounds__(NTHR, 2) fwd_megakernel(Params p_formal) {
    extern __shared__ __attribute__((aligned(16))) unsigned char lds_raw[];
    LAS unsigned char* lds = (LAS unsigned char*)lds_raw;
    volatile LAS unsigned* MISC = (volatile LAS unsigned*)(lds + MISC_OFF);
#define MODV ((float*)(p.ws + WS_MODV))
#define ROPE ((float*)(p.ws + WS_ROPE))
#define XC ((float*)(p.ws + WS_XC))
#define WB (p.ws + WS_WB)
#define WIN_T ((bf16_t*)(WB + WB_WIN))
#define WBP_T ((bf16_t*)(WB + WB_WBP))
#define WBA_T ((bf16_t*)(WB + WB_WBA))
#define WBS_T ((bf16_t*)(WB + WB_WBS))
#define WOUT_T ((bf16_t*)(WB + WB_WOUT))
#define WFI_T ((bf16_t*)(WB + WB_WFI))
#define WFO_T ((bf16_t*)(WB + WB_WFO))
#define WSP ((bf16_t*)(WB + WB_WSP))
#define H ((bf16_t*)(p.ws + WS_H))
#define ZPOOL ((bf16_t*)(p.ws + WS_ZPOOL))
#define SV ((bf16_t*)(p.ws + WS_SV))
#define YACC ((float*)(p.ws + WS_YACC))
#define QB ((bf16_t*)(p.ws + WS_Q))
#define KB ((bf16_t*)(p.ws + WS_KB))
#define VT ((bf16_t*)(p.ws + WS_VT))
#define UB ((bf16_t*)(p.ws + WS_U))
#define GATES ((bf16_t*)(p.ws + WS_GATES))
#define ACT ((bf16_t*)(p.ws + WS_ACT))
#define POOLED ((bf16_t*)(p.ws + WS_POOLED))
#define YM ((bf16_t*)(p.ws + WS_YM))
#define YATT ((bf16_t*)(p.ws + WS_YATT))
#define YSG ((bf16_t*)(p.ws + WS_YSG))
#define XL (p.out)


    for (int u = threadIdx.x; u < (LDS_BYTES - LDSCTL_OFF) / 4; u += NTHR) ((LAS unsigned*)(lds + LDSCTL_OFF))[u] = 0u;
    __syncthreads();
    typedef const __attribute__((address_space(4))) Params* KP;
    const int ph_lo = p_formal.ph_lo, ph_hi = p_formal.ph_hi;
    const bool multi = (ph_hi - ph_lo) > 1;
    unsigned* ctl0 = (unsigned*)(p_formal.ws + WS_CTL);
    if (multi) (void)xcd_barrier_post(ctl0 + CW_BAR, MISC + 8);

    for (int ph = ph_lo, rep = 0; ph < ph_hi; ) {
        KP kp = (KP)__builtin_amdgcn_kernarg_segment_ptr(); asm volatile("" : "+s"(kp));
        const __attribute__((address_space(4))) Params& p = *kp;
        int tid = threadIdx.x; asm volatile("" : "+v"(tid));
        int bx = blockIdx.x; asm volatile("" : "+s"(bx));
        int G = gridDim.x; asm volatile("" : "+s"(G));
        const int lane = tid & 63, wave = __builtin_amdgcn_readfirstlane(tid >> 6);
        const int gw = bx * NWAVES + wave, NGW = G * NWAVES;
        const long gtid = (long)bx * NTHR + tid, NGT = (long)G * NTHR;
        if (ph == 1 + 8 * (DEPTH - 1) + 5 && REPMASK == 0) { ++ph; continue; }
        if (ph > ph_lo && rep == 0) {
            if (ph_lo < 0) { cg::this_grid().sync(); }
            else { XcdBarrier bb; bb.bar = (unsigned*)(p.ws + WS_CTL) + CW_BAR; bb.x = xb_xcc_id(); bb.st = MISC + 8; xcd_barrier(bb);
#ifdef BAR2
                xcd_barrier(bb);
#endif
            }
        }
        if (ph == 0) { if constexpr (PHMASK & 1) {
            if (gtid < 1024) {
                const int pos = (int)gtid >> 4, j = (int)gtid & 15;
                const float inv = exp2f(-(float)j * 0.830482023721841f);
                const float ang = (float)pos * inv;
                const float n = rintf(ang * 0.15915494309189535f);
                float r = fmaf(-n, 6.28125f, ang); r = fmaf(-n, 1.9353071795864769e-3f, r);
                const float rev = r * 0.15915494309189535f;
                ROPE[2 * gtid] = __builtin_amdgcn_cosf(rev); ROPE[2 * gtid + 1] = __builtin_amdgcn_sinf(rev);
            }
            {
                LAS float* sc = (LAS float*)lds;
                LAS float* red = (LAS float*)(lds + 36864);
                for (int i = tid; i < 9 * 1024; i += NTHR) { const float v = (i < 8192) ? p.c[i] : p.c_ctx[i - 8192]; sc[i] = siluf_(v); }
                __syncthreads();
                const int cq = tid & 31, ks = tid >> 5;
                for (int unit = bx; unit < DEPTH * 48; unit += G) {
                    const int l = unit / 48, n0 = (unit % 48) * 128;
                    f32x4 acc[9];
#pragma unroll
                    for (int b = 0; b < 9; ++b) acc[b] = (f32x4){0.f, 0.f, 0.f, 0.f};
                    const float* wp = p.w_mod + ((size_t)l * 1024 + ks * 64) * 6144 + n0 + cq * 4;
#pragma unroll 2
                    for (int k4 = 0; k4 < 64; k4 += 4) {
                        const f32x4 w0 = *(const f32x4*)(wp + (size_t)(k4 + 0) * 6144), w1 = *(const f32x4*)(wp + (size_t)(k4 + 1) * 6144),
                                    w2 = *(const f32x4*)(wp + (size_t)(k4 + 2) * 6144), w3 = *(const f32x4*)(wp + (size_t)(k4 + 3) * 6144);
#pragma unroll
                        for (int b = 0; b < 9; ++b) { const f32x4 s4 = *(const LAS f32x4*)(sc + b * 1024 + ks * 64 + k4); acc[b] += w0 * s4[0] + w1 * s4[1] + w2 * s4[2] + w3 * s4[3]; }
                    }
#pragma unroll
                    for (int b = 0; b < 9; ++b) *(LAS f32x4*)(red + (ks * 9 + b) * 128 + cq * 4) = acc[b];
                    __syncthreads();
                    for (int i = tid; i < 9 * 128; i += NTHR) {
                        const int b = i >> 7, cc = i & 127; float sum = p.b_mod[l * 6144 + n0 + cc];
#pragma unroll
                        for (int k2 = 0; k2 < 16; ++k2) sum += red[(k2 * 9 + b) * 128 + cc];
                        MODV[((size_t)l * 9 + b) * 6144 + n0 + cc] = sum;
                    }
                    __syncthreads();
                }
            }
        } } else if (ph == NPH - 1) {
        } else {
            const int l = (ph - 1) >> 3, sub = (ph - 1) & 7;
            const float* modv = MODV + (size_t)l * 9 * 6144;
            const bool lastl = (l == DEPTH - 1);
            const int Mrows = lastl ? ML : MT;
            if (sub == 0 || sub == 5) { if constexpr (PHMASK & 2) {
                if (sub == 0) {
                    LAS float* scr = (LAS float*)(lds + wave * 16384);
                    const float* w_in = p.w_in + (size_t)l * DM * D_IN; const float* wba = p.wba + (size_t)l * 512 * DM; const float* wbs = p.wbs + (size_t)l * 512 * DM;
                    const float* w_out = p.w_out + (size_t)l * DM * DM; const float* wfi = p.wfi + (size_t)l * DM * 2 * D_FF; const float* wfo = p.wfo + (size_t)l * D_FF * DM;
                    constexpr int I_IN = (DM / 64) * (D_IN / 32), I_BR = (512 / 64) * (DM / 32), I_OUT = (DM / 64) * (DM / 32), I_FI = (DM / 64) * (2 * D_FF / 32), I_FO = (D_FF / 64) * (DM / 32);
                    constexpr int NITEMS = I_IN + 2 * I_BR + I_OUT + I_FI + I_FO;
                    for (int it = gw; it < NITEMS; it += NGW) {
                        int r = it;
                        if (r < I_IN) { transpose_item<0>(w_in, DM, D_IN, WIN_T, scr, r, lane); continue; } r -= I_IN;
                        if (r < I_BR) { transpose_item<0>(wba, 512, DM, WBA_T, scr, r, lane); continue; } r -= I_BR;
                        if (r < I_BR) { transpose_item<0>(wbs, 512, DM, WBS_T, scr, r, lane); continue; } r -= I_BR;
                        if (r < I_OUT) { transpose_item<0>(w_out, DM, DM, WOUT_T, scr, r, lane); continue; } r -= I_OUT;
                        if (r < I_FI) { transpose_item<1>(wfi, DM, 2 * D_FF, WFI_T, scr, r, lane); continue; } r -= I_FI;
                        transpose_item<0>(wfo, D_FF, DM, WFO_T, scr, r, lane);
                    }
                    const float* wpool = p.w_pool + (size_t)l * 4 * 128 * 128; const float* pscale = p.pool_scale + (size_t)l * 512; const float* wbp = p.wbp + (size_t)l * 512 * DM;
                    for (int task = gw; task < 256; task += NGW) {
                        const int g = task >> 6, n0 = (task & 63) * 16, fr = lane & 15, fq = lane >> 4;
                        bf16x8 bfr[4]; f32x4 psv[4][2];
#pragma unroll
                        for (int ks = 0; ks < 4; ++ks) {
                            const float* bp = wbp + (size_t)(g * 128 + ks * 32 + fq * 8) * DM + n0 + fr;
                            u32x4 w; w.x = pk2(bp[0], bp[DM]); w.y = pk2(bp[2 * DM], bp[3 * DM]); w.z = pk2(bp[4 * DM], bp[5 * DM]); w.w = pk2(bp[6 * DM], bp[7 * DM]);
                            bfr[ks] = __builtin_bit_cast(bf16x8, w);
                            psv[ks][0] = *(const f32x4*)(pscale + g * 128 + ks * 32 + fq * 8); psv[ks][1] = *(const f32x4*)(pscale + g * 128 + ks * 32 + fq * 8 + 4);
                        }
#pragma unroll 2
                        for (int ct = 0; ct < 8; ++ct) {
                            f32x4 acc = (f32x4){0.f, 0.f, 0.f, 0.f};
#pragma unroll
                            for (int ks = 0; ks < 4; ++ks) {
                                const float* ap = wpool + (size_t)(g * 128 + ct * 16 + fr) * 128 + ks * 32 + fq * 8;
                                const f32x4 a0 = *(const f32x4*)ap * psv[ks][0], a1 = *(const f32x4*)(ap + 4) * psv[ks][1];
                                u32x4 w; w.x = pk2(a0[0], a0[1]); w.y = pk2(a0[2], a0[3]); w.z = pk2(a1[0], a1[1]); w.w = pk2(a1[2], a1[3]);
                                acc = __builtin_amdgcn_mfma_f32_16x16x32_bf16(__builtin_bit_cast(bf16x8, w), bfr[ks], acc, 0, 0, 0);
                            }
                            st4bf(WBP_T + (size_t)(n0 + fr) * 512 + g * 128 + ct * 16 + fq * 4, acc);
                        }
                    }
                    const float* wsp = p.w_sp + (size_t)l * 4 * 128 * 128;
                    for (long i = gtid; i < 4 * 128 * 128 / 2; i += NGT) {
                        const int rp = (int)(2 * i) & 127; const long base = 2 * i - rp;
                        const int r0 = (rp & 64) + 16 * (rp & 3) + ((rp & 63) >> 2), r1 = (rp & 64) + 16 * ((rp + 1) & 3) + (((rp + 1) & 63) >> 2);
                        ((unsigned*)WSP)[i] = pk2(wsp[base + r0], wsp[base + r1]); }
                }
                if (sub == 0) { float* ssq = (float*)(p.ws + WS_SSQ); for (long i = gtid; i < MT; i += NGT) ssq[i] = 0.f; }
                const float* gain = (sub == 0 ? p.n1g : p.n2g) + (size_t)l * DM; const int si = (sub == 0) ? 0 : 3;
                const int nrows = (sub == 0) ? MT : Mrows;
                const int npend = (sub == 5) ? (lastl ? 0 : 4) : (l > 0 ? 6 : 0);
                const int mfirst = (l == 0 && sub == 0) ? 0 : ML;
                for (int m = mfirst + gw; m < nrows; m += NGW) {
                    const float* xrow; float* xdst; const float* mv; int np = 0; f32x4 va[4];
                    if (m < ML) { xdst = XL + (size_t)m * DM; xrow = (l == 0 && sub == 0) ? p.x + (size_t)m * DM : xdst; mv = modv + (m >> 11) * 6144; }
                    else { xdst = XC + (size_t)(m - ML) * DM; xrow = (l == 0) ? p.ctx + (size_t)(m - ML) * DM : xdst; mv = modv + 8 * 6144; np = npend; }
                    norm_load(va, xrow, lane, (const float*)(p.ws + WS_SLAB) + (size_t)(m - ML) * DM, np);
                    norm_finish(va, xdst, np, gain, mv + si * 1024, mv + (si + 1) * 1024, H + (size_t)m * DM, lane);
                }
            } } else if (sub == 1) { if constexpr (PHMASK & 4) {
                pg8::Gemm g{H, WIN_T, Mrows, D_IN, DM}; pg8::StaticOrder S; S.init(Mrows, D_IN, G, bx);
                EpiE1 E{p.ws, 0, 0};
                pg8::gemm_phase<EpiE1, pg8::StaticOrder, true, true>(lds, g, S, E, tid);
                if (lastl) {
                    pg8::Gemm g2{H + (size_t)ML * DM, WIN_T + (size_t)1024 * DM, MC, 256, DM}; pg8::StaticOrder S2; S2.init(MC, 256, G, (G == 256) ? ((bx + 192) & 255) : bx);
                    EpiE1 E2{p.ws, ML, 1024};
                    pg8::gemm_phase<EpiE1, pg8::StaticOrder, true, true>(lds, g2, S2, E2, tid);
                }
            } } else if (sub == 2) { if constexpr (PHMASK & 8) {
                int nrx = (REPMASK >> 8) ? 2 : 1; if (REPMASK >> 8) asm volatile("" : "+s"(nrx)); const int nra = ((REPMASK >> 8) & 1) ? nrx : 1, nrs = ((REPMASK >> 9) & 1) ? nrx : 1, nrp = ((REPMASK >> 10) & 1) ? nrx : 1;
                for (int rr = 0; rr < nra; ++rr)
                for (int unit = bx; unit < (lastl ? 256 : 288); unit += G) attn_unit(unit, lds, QB, KB, VT, YATT, p.sink + l * 8, tid);
                __syncthreads();
                for (int rr = 0; rr < nrs; ++rr)
                for (int unit = G - 1 - bx; unit < (Mrows / 128) * 4; unit += G) sg_unit(unit, lds, SV, (const float*)(p.ws + WS_SSQ), UB, YSG, WSP, p.sgg + (size_t)l * 512, p.b_sp + (size_t)l * 512, tid);
                const int pskip = (!lastl && G > 64) ? 32 : 0; const long pg0 = gtid - (long)pskip * NTHR, pgn = NGT - (long)pskip * NTHR;
                if (pg0 >= 0) for (int rr = 0; rr < nrp; ++rr) { pool_pass<0>(p.ws, Mrows, pg0, pgn); pool_pass<1>(p.ws, Mrows, pg0, pgn); pool_pass<2>(p.ws, Mrows, pg0, pgn); pool_pass<3>(p.ws, Mrows, pg0, pgn); }
            } } else if (sub == 3) { if constexpr (PHMASK & 16) {
                pg8::StaticOrder S; S.init(Mrows, 2 * DM, G, bx);
                pg8::Gemm3 g{POOLED, YATT, YSG, WBP_T, WBA_T, WBS_T, Mrows, DM, 512};
                E2H E{p.ws};
                pg8::gemm_phase_h1<E2H, pg8::StaticOrder>(lds, g, S, E, tid);
            } } else if (sub == 4 || sub == 7) { if constexpr (PHMASK & 32) {
                pg8::Gemm g{sub == 4 ? YM : ACT, sub == 4 ? WOUT_T : WFO_T, Mrows, DM, sub == 4 ? DM : D_FF}; TailOrder S; S.init(sub == 4 ? DM : D_FF, G, bx, !lastl);
                const int moff_ = l * 9 * 6144 + (sub == 4 ? 2 : 5) * 1024;
                const bool l0 = (l == 0 && sub == 4);
                const float* ngain_ = (sub == 4) ? p.n2g + (size_t)l * DM : (lastl ? p.fgain : p.n1g + (size_t)(l + 1) * DM);
                const int noff_ = (sub == 4) ? l * 9 * 6144 + 3 * 1024 : (lastl ? -1 : (l + 1) * 9 * 6144);
                unsigned* cnt_ = (unsigned*)(p.ws + WS_CTL) + CW_XCNT + ((l * 2 + (sub == 4 ? 0 : 1)) * 64) * 64;
                EpiResNorm E{(float*)(p.ws + WS_XF), l0 ? p.x : (const float*)nullptr, p.ws, moff_, ngain_, noff_, XL, cnt_};
                pg8::gemm_phase<EpiResNorm, TailOrder, true, true>(lds, g, S, E, tid);
            } } else { if constexpr (PHMASK & 64) {
                pg8::Gemm g{H, WFI_T, Mrows, 2 * D_FF, DM}; pg8::StaticOrder S; S.init(Mrows, 2 * D_FF, G, bx);
                EpiE4 E{p.ws};
                pg8::gemm_phase<EpiE4, pg8::StaticOrder, true, true>(lds, g, S, E, tid);
            } }
        }
        if (REPMASK != 0 && rep == 0 && ph > 0 && ph < NPH - 1 && ((REPMASK >> ((ph - 1) & 7)) & 1)) rep = 1; else { rep = 0; ++ph; }
    }
}

extern "C" void kernel_launch(void* const* d_in, const int* in_sizes, int n_in, void* d_out, int out_size, void* d_ws, size_t ws_size, hipStream_t stream) {
    static int grid = 0;
    if (grid == 0) {
        if (n_in != 22 || out_size != ML * DM || ws_size < WS_END) { fprintf(stderr, "kernel_launch: unexpected shapes: n_in %d out %d ws %zu (need %zu)\n", n_in, out_size, ws_size, (size_t)WS_END); grid = -1; return; }
        int dev = 0, cus = 0, per_cu = 0;
        if (hipGetDevice(&dev) != hipSuccess || hipDeviceGetAttribute(&cus, hipDeviceAttributeMultiprocessorCount, dev) != hipSuccess) { grid = -1; return; }
        if (hipFuncSetAttribute((const void*)fwd_megakernel, hipFuncAttributeMaxDynamicSharedMemorySize, LDS_BYTES) != hipSuccess) { fprintf(stderr, "kernel_launch: hipFuncSetAttribute failed\n"); grid = -1; return; }
        if (hipOccupancyMaxActiveBlocksPerMultiprocessor(&per_cu, (const void*)fwd_megakernel, NTHR, LDS_BYTES) != hipSuccess || per_cu < 1) { fprintf(stderr, "kernel_launch: occupancy query says %d\n", per_cu); per_cu = 1; }
        (void)hipGetLastError();
        grid = cus * 1;
        fprintf(stderr, "kernel_launch: cus %d per_cu %d grid %d\n", cus, per_cu, grid);
    }
    if (grid < 0) return;
    (void)hipMemsetAsync((char*)d_ws + WS_CTL, 0, CTL_ZERO_BYTES, stream);
    Params p{};
    const float** pp = (const float**)&p;
    for (int i = 0; i < 22; ++i) pp[i] = (const float*)d_in[i];
    p.out = (float*)d_out; p.ws = (unsigned char*)d_ws;
#if MK_ONE_LAUNCH
    p.ph_lo = 0; p.ph_hi = NPH - 1;
    void* args[] = {&p};
    hipError_t e = hipLaunchCooperativeKernel((const void*)fwd_megakernel, dim3(grid), dim3(NTHR), args, LDS_BYTES, stream);
    if (e != hipSuccess) fprintf(stderr, "kernel_launch: cooperative launch failed: %s (grid %d)\n", hipGetErrorString(e), grid);
#else
    for (int ph = 0; ph < NPH; ++ph) {
        p.ph_lo = ph; p.ph_hi = ph + 1;
        hipLaunchKernelGGL(fwd_megakernel, dim3(grid), dim3(NTHR), LDS_BYTES, stream, p);
    }
#endif
}
```

```cpp
#include <hip/hip_runtime.h>
#include <hip/hip_cooperative_groups.h>
#include <cstdio>
#include <cstdint>
namespace cg = cooperative_groups;
namespace pg8 {
#define PG8_LAS __attribute__((address_space(3)))
typedef unsigned short bf16_t;
typedef short bf16x8 __attribute__((ext_vector_type(8)));
typedef float f32x4 __attribute__((ext_vector_type(4)));
typedef unsigned u32x4 __attribute__((ext_vector_type(4)));
constexpr int BM = 256, BK = 64, HALF = 128, HTB = HALF * BK * 2  , STAGE_BYTES = 8 * HTB, NXCD = 8, WGM = 8;

__host__ __device__ __forceinline__ int lds_byte(int r, int c) { const int st = (r >> 4) * 2 + (c >> 5), rr = r & 15, cc = c & 31, ob = rr * 64 + cc * 2; return st * 1024 + (ob ^ (((ob >> 9) & 1) << 5)); }
__host__ __device__ __forceinline__ void stage_rc(int b, int& R, int& C) { const int st = b / 1024, sb = b % 1024, swz = sb ^ (((sb >> 9) & 1) << 5); R = (st >> 1) * 16 + swz / 64; C = (st & 1) * 32 + (swz % 64) / 2; }
__host__ __device__ __forceinline__ int perm32(int rho) { const int n = rho >> 4, i = rho & 15; return 8 * (i >> 2) + 4 * n + (i & 3); }

struct Unit { int pm, pn, k0b, nt; };
struct Gemm { const bf16_t* A; const bf16_t* Bt; int M, N, K; };

struct StaticOrder {
    int nM, nN, nwg, G, c;
    __host__ __device__ __forceinline__ void init(int M, int N, int G_, int c_) { nM = M / BM; nN = N / BM; nwg = nM * nN; G = G_; c = c_; }
    __host__ __device__ __forceinline__ bool next(int i, Unit& u) const {
        const long L = (long)i * G + c; if (L >= nwg) return false;
        int wgid = (int)L; { const int q = nwg / NXCD, r = nwg % NXCD, xcd = wgid % NXCD, off = wgid / NXCD; wgid = (xcd < r ? xcd * (q + 1) : r * (q + 1) + (xcd - r) * q) + off; }
        const int nig = WGM * nN, gid = wgid / nig, fm = gid * WGM, gsz = (nM - fm) < WGM ? (nM - fm) : WGM;
        u.pm = fm + ((wgid % nig) % gsz); u.pn = (wgid % nig) / gsz; u.k0b = 0; u.nt = 0; return true;
    }
    __device__ __forceinline__ void a_ready(const Unit&) const {}
    __device__ __forceinline__ void done(const Unit&) const {}
};

template <class Epi, class Sched, bool ALIGN_EPI = false, bool SP2 = false>
__device__ __forceinline__ void gemm_phase(PG8_LAS unsigned char* lds, const Gemm g, const Sched& S, const Epi& E, const int tid) {
    const int  wid = __builtin_amdgcn_readfirstlane(tid >> 6), lane = tid & 63, wr = wid >> 2, wc = wid & 3, fr = lane & 15, fq = lane >> 4;
    const int K = g.K, nt = K / BK;
    unsigned voffA[2], voffB[2];
#pragma unroll
    for (int i = 0; i < 2; ++i) { int R, C; stage_rc(tid * 16 + i * 8192, R, C); const int Rb = Epi::PERM ? ((R & ~31) + perm32(R & 31)) : R;
        voffA[i] = (unsigned)(R * K + C) * 2u; voffB[i] = (unsigned)(Rb * K + C) * 2u; }
    const size_t kstep = (size_t)(BK * 2);
    const size_t hstep = (size_t)HALF * K * 2;
    const size_t tstep = 2 * hstep;
    const unsigned ldsw = (unsigned)wid * 1024u;
    const int aoff = lds_byte(wr * 64 + fr, fq * 8), boff = lds_byte(wc * 32 + fr, fq * 8);
#define PG8_SA(b, h) (((b) * 2 + (h)) * HTB)
#define PG8_SB(b, h) ((4 + (b) * 2 + (h)) * HTB)
#define PG8_STAGE(bufoff, gbase, voff) do { _Pragma("unroll") for (int _i = 0; _i < 2; ++_i) \
        __builtin_amdgcn_global_load_lds((const unsigned*)((const char*)(gbase) + (voff)[_i]), (PG8_LAS unsigned*)(lds + (bufoff) + ldsw + _i * 8192), 16, 0, 0); } while (0)
#define PG8_LDA(dst, b, h) do { _Pragma("unroll") for (int m = 0; m < 4; ++m) _Pragma("unroll") for (int k = 0; k < 2; ++k) dst[m][k] = *(const PG8_LAS bf16x8*)(lds + PG8_SA(b, h) + aoff + m * 2048 + k * 1024); } while (0)
#define PG8_LDB(dst, b, h) do { _Pragma("unroll") for (int n = 0; n < 2; ++n) _Pragma("unroll") for (int k = 0; k < 2; ++k) dst[n][k] = *(const PG8_LAS bf16x8*)(lds + PG8_SB(b, h) + boff + n * 2048 + k * 1024); } while (0)
#define PG8_MMA(ai, bj, At, Bt) do { __builtin_amdgcn_s_setprio(1); _Pragma("unroll") for (int m = 0; m < 4; ++m) _Pragma("unroll") for (int n = 0; n < 2; ++n) _Pragma("unroll") for (int k = 0; k < 2; ++k) \
        acc[ai][bj][m][n] = __builtin_amdgcn_mfma_f32_16x16x32_bf16(Bt[n][k], At[m][k], acc[ai][bj][m][n], 0, 0, 0); __builtin_amdgcn_s_setprio(0); } while (0)
#define PG8_WAIT_V(n) asm volatile("s_waitcnt vmcnt(" #n ")" ::: "memory")
#define PG8_WAIT_L(n) asm volatile("s_waitcnt lgkmcnt(" #n ")" ::: "memory")
#define PG8_BAR __builtin_amdgcn_s_barrier()
#define PG8_SCHED __builtin_amdgcn_sched_barrier(0)
    Unit cur, nxt; int ui = 0;
    if (!S.next(0, cur)) return;
    f32x4 acc[2][2][4][2];
#pragma unroll
    for (int a = 0; a < 2; ++a)
#pragma unroll
        for (int b = 0; b < 2; ++b)
#pragma unroll
            for (int m = 0; m < 4; ++m)
#pragma unroll
                for (int n = 0; n < 2; ++n) acc[a][b][m][n] = (f32x4){0.f, 0.f, 0.f, 0.f};
    bf16x8 At[4][2], B0[2][2], B1[2][2];
    const char* cA = (const char*)g.A + (size_t)cur.pm * tstep + cur.k0b; const char* cB = (const char*)g.Bt + (size_t)cur.pn * tstep + cur.k0b;
    S.a_ready(cur);
    if constexpr (SP2) {
        PG8_STAGE(PG8_SB(0, 0), cB, voffB); PG8_STAGE(PG8_SB(0, 1), cB + hstep, voffB); PG8_STAGE(PG8_SA(0, 0), cA, voffA); PG8_STAGE(PG8_SA(0, 1), cA + hstep, voffA);
        if (wr == 1) PG8_BAR;
        PG8_WAIT_V(2); PG8_BAR;
        PG8_STAGE(PG8_SB(1, 0), cB + kstep, voffB); PG8_STAGE(PG8_SA(1, 0), cA + kstep, voffA); PG8_STAGE(PG8_SB(1, 1), cB + hstep + kstep, voffB);
        PG8_WAIT_V(6); PG8_BAR;
    } else {
        PG8_STAGE(PG8_SB(0, 0), cB, voffB); PG8_STAGE(PG8_SA(0, 0), cA, voffA); PG8_STAGE(PG8_SB(0, 1), cB + hstep, voffB); PG8_STAGE(PG8_SA(0, 1), cA + hstep, voffA);
        if (wr == 1) PG8_BAR;
        PG8_WAIT_V(4); PG8_BAR;
        PG8_STAGE(PG8_SB(1, 0), cB + kstep, voffB); PG8_STAGE(PG8_SA(1, 0), cA + kstep, voffA); PG8_STAGE(PG8_SB(1, 1), cB + hstep + kstep, voffB);
        PG8_WAIT_V(6); PG8_BAR;
    }
    for (;;) {
        const bool has_next = S.next(ui + 1, nxt);
        const char* nA = has_next ? (const char*)g.A + (size_t)nxt.pm * tstep + nxt.k0b : cA; const char* nB = has_next ? (const char*)g.Bt + (size_t)nxt.pn * tstep + nxt.k0b : cB;
        const int cnt = cur.nt ? cur.nt : nt;
        for (int t = 0; t < cnt; t += 2) {
            const bool last = (t == cnt - 2);
            const char* a1 = cA + (size_t)(t + 1) * kstep;
            const char* a2 = last ? nA : cA + (size_t)(t + 2) * kstep; const char* b2 = last ? nB : cB + (size_t)(t + 2) * kstep;
            const char* a3 = a2 + kstep; const char* b3 = b2 + kstep;
            if (last && has_next) S.a_ready(nxt);
            if constexpr (SP2) {
            PG8_LDB(B0, 0, 0); PG8_LDB(B1, 0, 1); PG8_SCHED; PG8_LDA(At, 0, 0); PG8_STAGE(PG8_SA(1, 1), a1 + hstep, voffA);
            PG8_WAIT_V(8); PG8_WAIT_L(0); PG8_BAR; PG8_MMA(0, 0, At, B0); PG8_MMA(0, 1, At, B1); PG8_BAR; PG8_SCHED;
            PG8_LDA(At, 0, 1); PG8_STAGE(PG8_SB(0, 0), b2, voffB); PG8_STAGE(PG8_SB(0, 1), b2 + hstep, voffB); PG8_STAGE(PG8_SA(0, 0), a2, voffA);
            PG8_WAIT_V(8); PG8_WAIT_L(0); PG8_BAR; PG8_MMA(1, 0, At, B0); PG8_MMA(1, 1, At, B1); PG8_BAR; PG8_SCHED;
            PG8_LDB(B0, 1, 0); PG8_LDB(B1, 1, 1); PG8_SCHED; PG8_LDA(At, 1, 0); PG8_STAGE(PG8_SA(0, 1), a2 + hstep, voffA);
            PG8_WAIT_V(8); PG8_WAIT_L(0); PG8_BAR; PG8_MMA(0, 0, At, B0); PG8_MMA(0, 1, At, B1); PG8_BAR; PG8_SCHED;
            PG8_LDA(At, 1, 1); PG8_STAGE(PG8_SB(1, 0), b3, voffB); PG8_STAGE(PG8_SB(1, 1), b3 + hstep, voffB); PG8_STAGE(PG8_SA(1, 0), a3, voffA);
            PG8_WAIT_V(8); PG8_WAIT_L(0); PG8_BAR; PG8_MMA(1, 0, At, B0); PG8_MMA(1, 1, At, B1); PG8_BAR; PG8_SCHED;
            } else {
            PG8_LDB(B0, 0, 0); PG8_SCHED; PG8_LDA(At, 0, 0); PG8_STAGE(PG8_SA(1, 1), a1 + hstep, voffA);
            PG8_WAIT_L(8); PG8_BAR; PG8_WAIT_L(0); PG8_MMA(0, 0, At, B0); PG8_BAR; PG8_SCHED;
            PG8_LDB(B1, 0, 1); PG8_STAGE(PG8_SB(0, 0), b2, voffB);
            PG8_BAR; PG8_WAIT_L(0); PG8_MMA(0, 1, At, B1); PG8_BAR;
            PG8_LDA(At, 0, 1); PG8_STAGE(PG8_SA(0, 0), a2, voffA);
            PG8_BAR; PG8_WAIT_L(0); PG8_MMA(1, 0, At, B0); PG8_BAR; PG8_SCHED;
            PG8_STAGE(PG8_SB(0, 1), b2 + hstep, voffB);
            PG8_WAIT_V(6); PG8_BAR; PG8_MMA(1, 1, At, B1); PG8_BAR;
            PG8_LDB(B0, 1, 0); PG8_SCHED; PG8_LDA(At, 1, 0); PG8_STAGE(PG8_SA(0, 1), a2 + hstep, voffA);
            PG8_WAIT_L(8); PG8_BAR; PG8_WAIT_L(0); PG8_MMA(0, 0, At, B0); PG8_BAR; PG8_SCHED;
            PG8_LDB(B1, 1, 1); PG8_STAGE(PG8_SB(1, 0), b3, voffB);
            PG8_BAR; PG8_WAIT_L(0); PG8_MMA(0, 1, At, B1); PG8_BAR;
            PG8_LDA(At, 1, 1); PG8_STAGE(PG8_SA(1, 0), a3, voffA);
            PG8_BAR; PG8_WAIT_L(0); PG8_MMA(1, 0, At, B0); PG8_BAR; PG8_SCHED;
            PG8_STAGE(PG8_SB(1, 1), b3 + hstep, voffB);
            PG8_WAIT_V(6); PG8_BAR; PG8_MMA(1, 1, At, B1); PG8_BAR;
            }
        }
        if constexpr (ALIGN_EPI) { if (wr == 0) PG8_BAR; }
        if constexpr (!Epi::AFTER_DRAIN) { E(acc, cur, wr, wc, fr, fq); S.done(cur); }
        else { if (has_next) { E(acc, cur, wr, wc, fr, fq); S.done(cur); } }
        if (!has_next) break;
#pragma unroll
        for (int a = 0; a < 2; ++a)
#pragma unroll
            for (int b = 0; b < 2; ++b)
#pragma unroll
                for (int m = 0; m < 4; ++m)
#pragma unroll
                    for (int n = 0; n < 2; ++n) acc[a][b][m][n] = (f32x4){0.f, 0.f, 0.f, 0.f};
        cur = nxt; cA = nA; cB = nB; ++ui;
        if constexpr (ALIGN_EPI) { if (wr == 1) PG8_BAR; }
    }
    PG8_WAIT_V(0);
    if constexpr (!ALIGN_EPI) { if (wr == 0) PG8_BAR; }
    PG8_BAR;
    if constexpr (Epi::AFTER_DRAIN) { E.fused(acc, cur, wr, wc, fr, fq, lds, wid, lane); S.done(cur); }
#undef PG8_SA
#undef PG8_SB
#undef PG8_STAGE
#undef PG8_LDA
#undef PG8_LDB
#undef PG8_MMA
#undef PG8_WAIT_V
#undef PG8_WAIT_L
#undef PG8_BAR
#undef PG8_SCHED
}
}
namespace pg8 {
struct Gemm3 { const bf16_t *A0, *A1, *A2, *B0, *B1, *B2; int M, N, K; };
template <class Epi, class Sched>
__device__ __forceinline__ void gemm_phase_h1(PG8_LAS unsigned char* lds, const Gemm3 g, const Sched& S, const Epi& E, const int tid) {
    const int wid = __builtin_amdgcn_readfirstlane(tid >> 6), lane = tid & 63, wr = wid >> 2, wc = wid & 3, fr = lane & 15, fq = lane >> 4;
    const int K = g.K, nt = K / BK;
    unsigned voff[2];
#pragma unroll
    for (int i = 0; i < 2; ++i) { int R, C; stage_rc(tid * 16 + i * 8192, R, C); voff[i] = (unsigned)(R * K + C) * 2u; }
    const size_t kstep = (size_t)(BK * 2);
    const size_t hstep = (size_t)HALF * K * 2;
    const size_t tstepA = 2 * hstep, tstepB = hstep;
    const unsigned ldsw = (unsigned)wid * 1024u;
    const int aoff = lds_byte(wr * 64 + fr, fq * 8), boff = lds_byte(wc * 32 + fr, fq * 8);
#define H1_SA(b, h) (((b) * 2 + (h)) * HTB)
#define H1_SB(b) ((4 + (b)) * HTB)
#define H1_STAGE(bufoff, gbase) do { _Pragma("unroll") for (int _i = 0; _i < 2; ++_i) \
        __builtin_amdgcn_global_load_lds((const unsigned*)((const char*)(gbase) + voff[_i]), (PG8_LAS unsigned*)(lds + (bufoff) + ldsw + _i * 8192), 16, 0, 0); } while (0)
#define H1_LDA(dst, b, h) do { _Pragma("unroll") for (int m = 0; m < 4; ++m) _Pragma("unroll") for (int k = 0; k < 2; ++k) dst[m][k] = *(const PG8_LAS bf16x8*)(lds + H1_SA(b, h) + aoff + m * 2048 + k * 1024); } while (0)
#define H1_LDB(dst, b) do { _Pragma("unroll") for (int n = 0; n < 2; ++n) _Pragma("unroll") for (int k = 0; k < 2; ++k) dst[n][k] = *(const PG8_LAS bf16x8*)(lds + H1_SB(b) + boff + n * 2048 + k * 1024); } while (0)
#define H1_MMA(ai) do { __builtin_amdgcn_s_setprio(1); _Pragma("unroll") for (int m = 0; m < 4; ++m) _Pragma("unroll") for (int n = 0; n < 2; ++n) _Pragma("unroll") for (int k = 0; k < 2; ++k) \
        acc[ai][m][n] = __builtin_amdgcn_mfma_f32_16x16x32_bf16(B0[n][k], At[m][k], acc[ai][m][n], 0, 0, 0); __builtin_amdgcn_s_setprio(0); } while (0)
#define H1_WAIT_V(n) asm volatile("s_waitcnt vmcnt(" #n ")" ::: "memory")
#define H1_WAIT_L(n) asm volatile("s_waitcnt lgkmcnt(" #n ")" ::: "memory")
#define H1_BAR __builtin_amdgcn_s_barrier()
#define H1_SCHED __builtin_amdgcn_sched_barrier(0)
    Unit cur, nxt; int ui = 0, br = 0;
    if (!S.next(0, cur)) return;
    f32x4 acc[2][4][2], tot[2][4][2];
#pragma unroll
    for (int a = 0; a < 2; ++a)
#pragma unroll
        for (int m = 0; m < 4; ++m)
#pragma unroll
            for (int n = 0; n < 2; ++n) { acc[a][m][n] = (f32x4){0.f, 0.f, 0.f, 0.f}; tot[a][m][n] = (f32x4){0.f, 0.f, 0.f, 0.f}; }
    bf16x8 At[4][2], B0[2][2];
    const char* cA = (const char*)g.A0 + (size_t)cur.pm * tstepA; const char* cB = (const char*)g.B0 + (size_t)cur.pn * tstepB;
    H1_STAGE(H1_SB(0), cB); H1_STAGE(H1_SA(0, 0), cA); H1_STAGE(H1_SA(0, 1), cA + hstep);
    if (wr == 1) H1_BAR;
    H1_WAIT_V(2); H1_BAR;
    H1_STAGE(H1_SB(1), cB + kstep); H1_STAGE(H1_SA(1, 0), cA + kstep);
    H1_WAIT_V(4); H1_BAR;
    for (;;) {
        bool has_next; int nbr;
        if (br < 2) { has_next = true; nxt = cur; nbr = br + 1; } else { has_next = S.next(ui + 1, nxt); nbr = 0; }
        const bf16_t* nAb = (nbr == 0) ? g.A0 : (nbr == 1 ? g.A1 : g.A2); const bf16_t* nBb = (nbr == 0) ? g.B0 : (nbr == 1 ? g.B1 : g.B2);
        const char* nA = has_next ? (const char*)nAb + (size_t)nxt.pm * tstepA : cA; const char* nB = has_next ? (const char*)nBb + (size_t)nxt.pn * tstepB : cB;
        for (int t = 0; t < nt; t += 2) {
            const bool last = (t == nt - 2);
            const char* a1 = cA + (size_t)(t + 1) * kstep;
            const char* a2 = last ? nA : cA + (size_t)(t + 2) * kstep; const char* b2 = last ? nB : cB + (size_t)(t + 2) * kstep;
            const char* a3 = a2 + kstep; const char* b3 = b2 + kstep;
            H1_LDB(B0, 0); H1_SCHED; H1_LDA(At, 0, 0); H1_STAGE(H1_SA(1, 1), a1 + hstep);
            H1_WAIT_V(6); H1_WAIT_L(0); H1_BAR; H1_MMA(0); H1_BAR; H1_SCHED;
            H1_LDA(At, 0, 1); H1_STAGE(H1_SB(0), b2); H1_STAGE(H1_SA(0, 0), a2);
            H1_WAIT_V(6); H1_WAIT_L(0); H1_BAR; H1_MMA(1); H1_BAR; H1_SCHED;
            H1_LDB(B0, 1); H1_SCHED; H1_LDA(At, 1, 0); H1_STAGE(H1_SA(0, 1), a2 + hstep);
            H1_WAIT_V(6); H1_WAIT_L(0); H1_BAR; H1_MMA(0); H1_BAR; H1_SCHED;
            H1_LDA(At, 1, 1); H1_STAGE(H1_SB(1), b3); H1_STAGE(H1_SA(1, 0), a3);
            H1_WAIT_V(6); H1_WAIT_L(0); H1_BAR; H1_MMA(1); H1_BAR; H1_SCHED;
        }
        if (wr == 0) H1_BAR;
        E.seg(acc, tot, cur, br, wr, wc, fr, fq);
        if (!has_next) break;
#pragma unroll
        for (int a = 0; a < 2; ++a)
#pragma unroll
            for (int m = 0; m < 4; ++m)
#pragma unroll
                for (int n = 0; n < 2; ++n) acc[a][m][n] = (f32x4){0.f, 0.f, 0.f, 0.f};
        if (br == 2) ++ui;
        cur = nxt; cA = nA; cB = nB; br = nbr;
        if (wr == 1) H1_BAR;
    }
    H1_WAIT_V(0);
    H1_BAR;
#undef H1_SA
#undef H1_SB
#undef H1_STAGE
#undef H1_LDA
#undef H1_LDB
#undef H1_MMA
#undef H1_WAIT_V
#undef H1_WAIT_L
#undef H1_BAR
#undef H1_SCHED
}
}

constexpr int DM = 1024, NBATCH = 8, SEQ = 2048, DEPTH = 4, CTXL = 256;
constexpr int ML = NBATCH * SEQ, MC = NBATCH * CTXL, MT = ML + MC;
constexpr int D_IN = 5376, D_FF = 2816;
constexpr float NORM_EPS = 1e-6f;
constexpr float LOG2E = 1.4426950408889634f;
constexpr float QSCALE = 0.125f * LOG2E;
constexpr int NWAVES = 8, NTHR = 512;
#ifndef MK_ONE_LAUNCH
#define MK_ONE_LAUNCH 1
#endif

constexpr size_t MiB = 1u << 20;
constexpr size_t WS_CTL = 0, CTL_ZERO_BYTES = 448 * 1024;
constexpr int CW_XCNT = 81920;
constexpr size_t WS_XSLOT = 2 * MiB + 262144;
constexpr size_t WS_MODV = 1 * MiB;
constexpr size_t WS_ROPE = 2 * MiB;
constexpr size_t WS_SSQ = 2 * MiB + 65536;
constexpr size_t WS_XC = 3 * MiB;
constexpr size_t WS_WB = 11 * MiB;
constexpr size_t WB_WIN = 0, WB_WBP = 11010048, WB_WBA = WB_WBP + MiB, WB_WBS = WB_WBA + MiB, WB_WOUT = WB_WBS + MiB,
                 WB_WFI = WB_WOUT + 2 * MiB, WB_WFO = WB_WFI + 11534336, WB_WSP = WB_WFO + 5767168, WB_END = WB_WSP + 131072;
static_assert(WB_END <= 34 * MiB, "weights");
constexpr size_t WS_H = 45 * MiB;
constexpr size_t WS_ZPOOL = 81 * MiB;
constexpr size_t WS_SV = 99 * MiB;
constexpr size_t WS_YACC = WS_H;
constexpr size_t WS_Q = 117 * MiB;
constexpr size_t WS_KB = 135 * MiB;
constexpr size_t WS_VT = WS_KB + 4718592;
constexpr size_t WS_U = 144 * MiB;
constexpr size_t WS_GATES = 162 * MiB;
constexpr size_t WS_ACT = WS_GATES;
constexpr size_t WS_POOLED = 270 * MiB;
constexpr size_t WS_YM = 288 * MiB;
constexpr size_t WS_YATT = 324 * MiB;
constexpr size_t WS_YSG = 342 * MiB;
constexpr size_t WS_SLAB = 81 * MiB;
constexpr size_t WS_XF = 360 * MiB;
constexpr size_t WS_END = 424 * MiB;
constexpr size_t VT_CTX_OFF = (size_t)NBATCH * 2 * 64 * SEQ;
constexpr int CW_BAR = 4096;

constexpr int RING_BYTES = 131072, LDSCTL_OFF = RING_BYTES, MISC_OFF = LDSCTL_OFF + 320, LDS_BYTES = 147456;

#define GAS __attribute__((address_space(1)))
#define LAS __attribute__((address_space(3)))
typedef unsigned short bf16_t;
typedef short bf16x8 __attribute__((ext_vector_type(8)));
typedef short s16x4 __attribute__((ext_vector_type(4)));
typedef float f32x4 __attribute__((ext_vector_type(4)));
typedef float f32x16 __attribute__((ext_vector_type(16)));
typedef unsigned u32x4 __attribute__((ext_vector_type(4)));
typedef unsigned u32x2 __attribute__((ext_vector_type(2)));
typedef float f32x2_t __attribute__((ext_vector_type(2)));
typedef __bf16 bf16x2_t __attribute__((ext_vector_type(2)));
__device__ __forceinline__ unsigned pk2(float lo, float hi) { f32x2_t v = {lo, hi}; bf16x2_t b = __builtin_convertvector(v, bf16x2_t); return __builtin_bit_cast(unsigned, b); }
__device__ __forceinline__ float bf2f(unsigned short v) { return __uint_as_float((unsigned)v << 16); }
__device__ __forceinline__ float bflo(unsigned w) { return __uint_as_float(w << 16); }
__device__ __forceinline__ float bfhi(unsigned w) { return __uint_as_float(w & 0xffff0000u); }
__device__ __forceinline__ void st4bf(bf16_t* p, f32x4 v) { u32x2 w; w.x = pk2(v[0], v[1]); w.y = pk2(v[2], v[3]); *(u32x2*)p = w; }
__device__ __forceinline__ void st8bf_x(bf16_t* p, f32x4 lo, f32x4 hi, bool odd) {
    unsigned a0 = pk2(lo[0], lo[1]), a1 = pk2(lo[2], lo[3]), b0 = pk2(hi[0], hi[1]), b1 = pk2(hi[2], hi[3]);
    auto r0 = __builtin_amdgcn_permlane16_swap(a0, b0, false, false); a0 = r0[0]; b0 = r0[1];
    auto r1 = __builtin_amdgcn_permlane16_swap(a1, b1, false, false); a1 = r1[0]; b1 = r1[1];
    *(u32x4*)(p + (odd ? 12 : 0)) = (u32x4){a0, a1, b0, b1};
}
__device__ __forceinline__ float fast_exp2(float x) { return __builtin_amdgcn_exp2f(x); }
__device__ __forceinline__ float fast_rcp(float x) { return __builtin_amdgcn_rcpf(x); }
__device__ __forceinline__ float sigmoidf_(float x) { return fast_rcp(1.f + fast_exp2(-LOG2E * x)); }
__device__ __forceinline__ float siluf_(float x) { return x * sigmoidf_(x); }
__device__ __forceinline__ float gelu_tanh(float x) { const float y = 1.5957691216057308f * (x + 0.044715f * x * x * x); return x * fast_rcp(1.f + fast_exp2(-LOG2E * y)); }
__device__ __forceinline__ float wave_sum(float v) {
#pragma unroll
    for (int o = 1; o < 64; o <<= 1) v += __shfl_xor(v, o);
    return v;
}

#define XB_TMO      128
#define XB_XCNT(j)  (256  + 64 * (j))
#define XB_XSUB(j)  (1280 + 64 * (j))
#define XB_XGEN(j)  (2304 + 64 * (j))
#define XB_TOP      3328
#define XB_TOPGEN   3392
#define XCD_BAR_WORDS 3456
#define XB_SPIN_CAP (1u << 18)

__device__ __forceinline__ unsigned xb_ld(unsigned* p)              { return __hip_atomic_load(p, __ATOMIC_RELAXED, __HIP_MEMORY_SCOPE_AGENT); }
__device__ __forceinline__ unsigned xb_add(unsigned* p, unsigned v) { return __hip_atomic_fetch_add(p, v, __ATOMIC_RELAXED, __HIP_MEMORY_SCOPE_AGENT); }
__device__ __forceinline__ unsigned xb_xcc_id() { return (unsigned)__builtin_amdgcn_s_getreg((3 << 11) | 20) & 0xFu; }
#define XB_SPIN(cond, bar) do { unsigned _sp = 0; while (cond) { __builtin_amdgcn_s_sleep(1); \
    if ((++_sp & 255u) == 0u) { if (xb_ld(&(bar)[XB_TMO])) break; if (_sp > XB_SPIN_CAP) { atomicAdd(&(bar)[XB_TMO], 1u); break; } } } } while (0)

struct XcdBarrier {
    unsigned* bar; unsigned x;
    volatile LAS unsigned* st;
};

__device__ __forceinline__ XcdBarrier xcd_barrier_post(unsigned* bar, volatile LAS unsigned* st) {
    XcdBarrier b; b.bar = bar; b.x = xb_xcc_id(); b.st = st;
    if (threadIdx.x == 0) (void)xb_add(&bar[XB_XCNT(b.x)], 1u);
    return b;
}
__device__ __forceinline__ void xcd_barrier_complete(unsigned* bar, unsigned x, unsigned& nloc, unsigned& nx) {
    const unsigned G = gridDim.x * gridDim.y * gridDim.z;
    unsigned sum, cnt, mine, sp = 0u;
    for (;;) {
        sum = 0u; cnt = 0u; mine = 0u;
#pragma unroll
        for (unsigned j = 0; j < 16; ++j) { const unsigned c = xb_ld(&bar[XB_XCNT(j)]); sum += c; cnt += (c > 0u) ? 1u : 0u; mine = (j == x) ? c : mine; }
        if (sum == G) break;
        __builtin_amdgcn_s_sleep(1);
        if ((++sp & 255u) == 0u) { if (xb_ld(&bar[XB_TMO])) break; if (sp > XB_SPIN_CAP) { atomicAdd(&bar[XB_TMO], 1u); break; } }
    }
    nloc = mine > 0u ? mine : 1u; nx = cnt > 0u ? cnt : 1u;
}

__device__ __forceinline__ void xcd_barrier(const XcdBarrier& b) {
    asm volatile("s_waitcnt vmcnt(0)" ::: "memory");
    __syncthreads();
    if (threadIdx.x == 0) {
        unsigned* bar = b.bar;
        __builtin_amdgcn_s_waitcnt(0);
        unsigned nloc = b.st[0], nx = b.st[1];
        if (nloc == 0u) { xcd_barrier_complete(bar, b.x, nloc, nx); b.st[0] = nloc; b.st[1] = nx; }
        const unsigned old = xb_add(&bar[XB_XSUB(b.x)], 1u);
        const unsigned gen = old / nloc;
        if (old + 1u == (gen + 1u) * nloc) {
            __builtin_amdgcn_fence(__ATOMIC_RELEASE, "agent");
            asm volatile("s_waitcnt vmcnt(0)" ::: "memory");
            const unsigned og = xb_add(&bar[XB_TOP], 1u);
            const unsigned tg = og / nx;
            if (og + 1u == (tg + 1u) * nx) xb_add(&bar[XB_TOPGEN], 1u);
            else XB_SPIN(xb_ld(&bar[XB_TOPGEN]) == tg, bar);
            __builtin_amdgcn_fence(__ATOMIC_ACQUIRE, "agent");
            xb_add(&bar[XB_XGEN(b.x)], 1u);
            asm volatile("s_waitcnt vmcnt(0)" ::: "memory");
        } else {
            XB_SPIN(xb_ld(&bar[XB_XGEN(b.x)]) == gen, bar);
            __builtin_amdgcn_fence(__ATOMIC_ACQUIRE, "agent");
            asm volatile("s_waitcnt vmcnt(0)" ::: "memory");
        }
    }
    __syncthreads();
}


struct Params {
    const float *x, *c, *ctx, *c_ctx, *w_mod, *b_mod, *n1g, *n2g, *w_in, *w_pool, *pool_scale, *sink, *sgg, *w_sp, *b_sp, *wbp, *wba, *wbs, *w_out, *wfi, *wfo, *fgain;
    float* out; unsigned char* ws; int ph_lo, ph_hi;
};

template <class F> struct EpiPair {
    static constexpr bool PERM = false, AFTER_DRAIN = false;
    F f;
    __device__ __forceinline__ void operator()(const pg8::f32x4 (&acc)[2][2][4][2], const pg8::Unit& u, int wr, int wc, int fr, int fq) const {
#pragma unroll
        for (int ai = 0; ai < 2; ++ai)
#pragma unroll
            for (int m = 0; m < 4; ++m) {
                const int row = u.pm * 256 + ai * 128 + wr * 64 + m * 16 + fr;
#pragma unroll
                for (int bj = 0; bj < 2; ++bj) {
                    const int c0 = u.pn * 256 + bj * 128 + wc * 32 + 4 * fq;
                    f(row, c0, acc[ai][bj][m][0], acc[ai][bj][m][1]);
                }
                asm volatile("" ::: "memory");
            }
    }
};

struct EpiE1 {
    static constexpr bool PERM = false, AFTER_DRAIN = false;
    unsigned char* ws; int roff, coff;
    template <int R> __device__ __forceinline__ void elem(int row, int c0, f32x4 v0, f32x4 v1) const {
        const bool odd = (c0 >> 2) & 1;
        if constexpr (R == 0) { bf16_t* o = (bf16_t*)(ws + WS_ZPOOL) + (size_t)row * 512 + c0; st8bf_x(o, v0, v1, odd); }
        else if constexpr (R == 1 || R == 2) {
            if (row < ML) {
                const float* rope = (const float*)(ws + WS_ROPE);
                const int t = row & (SEQ - 1); const int pos = (c0 & 32) ? (t & 63) : (t >> 6);
                const f32x4* rp = (const f32x4*)(rope + (pos * 16 + (c0 & 15)) * 2);
                const f32x4 r0 = rp[0], r1 = rp[1];
                f32x4 a, b;
                a[0] = v0[0] * r0[0] - v1[0] * r0[1]; b[0] = v1[0] * r0[0] + v0[0] * r0[1];
                a[1] = v0[1] * r0[2] - v1[1] * r0[3]; b[1] = v1[1] * r0[2] + v0[1] * r0[3];
                a[2] = v0[2] * r1[0] - v1[2] * r1[1]; b[2] = v1[2] * r1[0] + v0[2] * r1[1];
                a[3] = v0[3] * r1[2] - v1[3] * r1[3]; b[3] = v1[3] * r1[2] + v0[3] * r1[3];
                v0 = a; v1 = b;
            }
            if constexpr (R == 1) { v0 = v0 * QSCALE; v1 = v1 * QSCALE; bf16_t* o = (bf16_t*)(ws + WS_Q) + (size_t)row * 512 + (c0 - 512); st8bf_x(o, v0, v1, odd); }
            else { bf16_t* o = (bf16_t*)(ws + WS_KB) + (size_t)row * 128 + (c0 - 1024); st8bf_x(o, v0, v1, odd); }
        }
        else if constexpr (R == 3) {
            bf16_t* vt = (bf16_t*)(ws + WS_VT);
            const int cc = c0 - 1152, hk = cc >> 6, d = cc & 63; size_t base, stride;
            if (row < ML) { const int b = row >> 11, pos = row & (SEQ - 1); base = ((size_t)((b * 2 + hk) * 64 + d)) * SEQ + pos; stride = SEQ; }
            else { const int r = row - ML, b = r >> 8, pos = r & (CTXL - 1); base = VT_CTX_OFF + ((size_t)((b * 2 + hk) * 64 + d)) * CTXL + pos; stride = CTXL; }
#pragma unroll
            for (int i = 0; i < 4; ++i) { vt[base + i * stride] = (bf16_t)(pk2(v0[i], 0.f) & 0xffffu); vt[base + (16 + i) * stride] = (bf16_t)(pk2(v1[i], 0.f) & 0xffffu); }
        }
        else if constexpr (R == 4 || R == 5) {
            f32x4 a, b;
#pragma unroll
            for (int i = 0; i < 4; ++i) { a[i] = gelu_tanh(v0[i]); b[i] = gelu_tanh(v1[i]); }
            if constexpr (R == 4) { bf16_t* o = (bf16_t*)(ws + WS_U) + (size_t)row * 512 + (c0 - 1280); st8bf_x(o, a, b, odd); }
            else {
                float ss = (a[0] * a[0] + a[1] * a[1]) + (a[2] * a[2] + a[3] * a[3]) + (b[0] * b[0] + b[1] * b[1]) + (b[2] * b[2] + b[3] * b[3]);
                ss += __shfl_xor(ss, 16); ss += __shfl_xor(ss, 32);
                if (((c0 >> 2) & 3) == 0) __hip_atomic_fetch_add((float*)(ws + WS_SSQ) + row, ss, __ATOMIC_RELAXED, __HIP_MEMORY_SCOPE_AGENT);
                bf16_t* o = (bf16_t*)(ws + WS_SV) + ((size_t)(row >> 7) * 512 + (c0 - 1792)) * 128 + (row & 127);
#pragma unroll
                for (int i = 0; i < 4; ++i) { o[i * 128] = (bf16_t)(pk2(a[i], 0.f) & 0xffffu); o[(16 + i) * 128] = (bf16_t)(pk2(b[i], 0.f) & 0xffffu); }
            }
        }
        else {
            f32x4 a, b;
#pragma unroll
            for (int i = 0; i < 4; ++i) { a[i] = sigmoidf_(v0[i]); b[i] = sigmoidf_(v1[i]); }
            const int cg = c0 - 2304;
            const size_t gi = ((((size_t)(row >> 8) * 24 + (cg >> 7)) * 8 + (((row >> 6) & 1) * 4 + ((cg >> 5) & 3))) * 64 + (((cg >> 2) & 3) * 16 + (row & 15))) * 64 + ((((row >> 7) & 1) * 4 + ((row >> 4) & 3)) * 8);
            u32x4 w; w.x = pk2(a[0], a[1]); w.y = pk2(a[2], a[3]); w.z = pk2(b[0], b[1]); w.w = pk2(b[2], b[3]);
            *(u32x4*)((bf16_t*)(ws + WS_GATES) + gi) = w;
        }
    }
    template <int BJ> __device__ __forceinline__ void sv_half_tile(const pg8::f32x4 (&acc)[2][2][4][2], int rowb, int c0) const {
#pragma unroll
        for (int ai = 0; ai < 2; ++ai) {
            f32x4 a[4], b[4];
#pragma unroll
            for (int m = 0; m < 4; ++m) {
                const int row = rowb + ai * 128 + m * 16;
#pragma unroll
                for (int i = 0; i < 4; ++i) { a[m][i] = gelu_tanh(acc[ai][BJ][m][0][i]); b[m][i] = gelu_tanh(acc[ai][BJ][m][1][i]); }
                float ss = (a[m][0] * a[m][0] + a[m][1] * a[m][1]) + (a[m][2] * a[m][2] + a[m][3] * a[m][3]) + (b[m][0] * b[m][0] + b[m][1] * b[m][1]) + (b[m][2] * b[m][2] + b[m][3] * b[m][3]);
                ss += __shfl_xor(ss, 16); ss += __shfl_xor(ss, 32);
                if (((c0 >> 2) & 3) == 0) __hip_atomic_fetch_add((float*)(ws + WS_SSQ) + row, ss, __ATOMIC_RELAXED, __HIP_MEMORY_SCOPE_AGENT);
            }
            const int row0 = rowb + ai * 128;
            bf16_t* o = (bf16_t*)(ws + WS_SV) + ((size_t)(row0 >> 7) * 512 + (c0 - 1792)) * 128 + (row0 & 64) + 4 * (row0 & 15);
#pragma unroll
            for (int i = 0; i < 4; ++i) {
                *(u32x2*)(o + i * 128) = (u32x2){pk2(a[0][i], a[1][i]), pk2(a[2][i], a[3][i])};
                *(u32x2*)(o + (16 + i) * 128) = (u32x2){pk2(b[0][i], b[1][i]), pk2(b[2][i], b[3][i])};
            }
            asm volatile("" ::: "memory");
        }
    }
    template <int R, int BJ> __device__ __forceinline__ void half_tile(const pg8::f32x4 (&acc)[2][2][4][2], int rowb, int c0) const {
        if constexpr (R == 5) { sv_half_tile<BJ>(acc, rowb, c0); return; }
#pragma unroll
        for (int ai = 0; ai < 2; ++ai)
#pragma unroll
            for (int m = 0; m < 4; ++m) { elem<R>(rowb + ai * 128 + m * 16, c0, acc[ai][BJ][m][0], acc[ai][BJ][m][1]); asm volatile("" ::: "memory"); }
    }
    template <int BJ> __device__ __forceinline__ void dispatch(const pg8::f32x4 (&acc)[2][2][4][2], int rowb, int cb, int c0) const {
        if (cb < 512) half_tile<0, BJ>(acc, rowb, c0);
        else if (cb < 1024) half_tile<1, BJ>(acc, rowb, c0);
        else if (cb < 1152) half_tile<2, BJ>(acc, rowb, c0);
        else if (cb < 1280) half_tile<3, BJ>(acc, rowb, c0);
        else if (cb < 1792) half_tile<4, BJ>(acc, rowb, c0);
        else if (cb < 2304) half_tile<5, BJ>(acc, rowb, c0);
        else half_tile<6, BJ>(acc, rowb, c0);
    }
    __device__ __forceinline__ void operator()(const pg8::f32x4 (&acc)[2][2][4][2], const pg8::Unit& u, int wr, int wc, int fr, int fq) const {
        const int rowb = u.pm * 256 + wr * 64 + fr + roff, cb0 = u.pn * 256 + coff, c00 = cb0 + wc * 32 + 4 * fq;
        dispatch<0>(acc, rowb, cb0, c00);
        dispatch<1>(acc, rowb, cb0 + 128, c00 + 128);
    }
};
struct E2F {
    unsigned char* ws; int pass;
    __device__ __forceinline__ void operator()(int row, int c0, f32x4 v0, f32x4 v1) const {
        const bf16_t* gates = (const bf16_t*)(ws + WS_GATES); float* yacc = (float*)(ws + WS_YACC); bf16_t* ym = (bf16_t*)(ws + WS_YM);
        const bf16_t* gp = gates + (size_t)row * 3072 + pass * 1024 + c0;
        const u32x2 g0 = *(const u32x2*)gp, g1 = *(const u32x2*)(gp + 16);
        f32x4 a, b;
        a[0] = bflo(g0.x) * v0[0]; a[1] = bfhi(g0.x) * v0[1]; a[2] = bflo(g0.y) * v0[2]; a[3] = bfhi(g0.y) * v0[3];
        b[0] = bflo(g1.x) * v1[0]; b[1] = bfhi(g1.x) * v1[1]; b[2] = bflo(g1.y) * v1[2]; b[3] = bfhi(g1.y) * v1[3];
        float* yp = yacc + (size_t)row * 1024 + c0;
        if (pass == 0) { *(f32x4*)yp = a; *(f32x4*)(yp + 16) = b; }
        else {
            a += *(const f32x4*)yp; b += *(const f32x4*)(yp + 16);
            if (pass == 1) { *(f32x4*)yp = a; *(f32x4*)(yp + 16) = b; }
            else { bf16_t* o = ym + (size_t)row * 1024 + c0; st4bf(o, a); st4bf(o + 16, b); }
        }
    }
};
struct E2H {
    unsigned char* ws;
    __device__ __forceinline__ void seg(const pg8::f32x4 (&acc)[2][4][2], pg8::f32x4 (&tot)[2][4][2], const pg8::Unit& u, int br, int wr, int wc, int fr, int fq) const {
        const bf16_t* gates = (const bf16_t*)(ws + WS_GATES); bf16_t* ym = (bf16_t*)(ws + WS_YM);
        const int c0 = u.pn * 128 + wc * 32 + 4 * fq;
#pragma unroll
        for (int ai = 0; ai < 2; ++ai)
#pragma unroll
            for (int m = 0; m < 4; ++m) {
                const int row = u.pm * 256 + ai * 128 + wr * 64 + m * 16 + fr;
                const size_t gi = ((((size_t)u.pm * 24 + (br * 8 + u.pn)) * 8 + (wr * 4 + wc)) * 64 + (fq * 16 + fr)) * 64 + (ai * 4 + m) * 8;
                const u32x4 gw4 = *(const u32x4*)(gates + gi);
                const u32x2 g0 = (u32x2){gw4.x, gw4.y}, g1 = (u32x2){gw4.z, gw4.w};
                const f32x4 v0 = acc[ai][m][0], v1 = acc[ai][m][1];
                f32x4 a, b;
                a[0] = bflo(g0.x) * v0[0]; a[1] = bfhi(g0.x) * v0[1]; a[2] = bflo(g0.y) * v0[2]; a[3] = bfhi(g0.y) * v0[3];
                b[0] = bflo(g1.x) * v1[0]; b[1] = bfhi(g1.x) * v1[1]; b[2] = bflo(g1.y) * v1[2]; b[3] = bfhi(g1.y) * v1[3];
                if (br == 0) { tot[ai][m][0] = a; tot[ai][m][1] = b; }
                else {
                    a += tot[ai][m][0]; b += tot[ai][m][1];
                    if (br == 1) { tot[ai][m][0] = a; tot[ai][m][1] = b; }
                    else { bf16_t* o = ym + (size_t)row * 1024 + c0; st8bf_x(o, a, b, fq & 1); }
                }
            }
    }
};
struct EResF {
    float* xl; unsigned char* ws; int moff;
    __device__ __forceinline__ void operator()(int row, int c0, f32x4 v0, f32x4 v1) const {
        float* xp; const float* mg; const float* modv = (const float*)(ws + WS_MODV) + moff; float* xc = (float*)(ws + WS_XC);
        if (row < ML) { xp = xl + (size_t)row * 1024; mg = modv + (row >> 11) * 6144; }
        else { xp = xc + (size_t)(row - ML) * 1024; mg = modv + 8 * 6144; }
        const f32x4 g0 = *(const f32x4*)(mg + c0), g1 = *(const f32x4*)(mg + c0 + 16);
        const f32x4 a = *(const f32x4*)(xp + c0), b = *(const f32x4*)(xp + c0 + 16);
        *(f32x4*)(xp + c0) = a + g0 * v0; *(f32x4*)(xp + c0 + 16) = b + g1 * v1;
    }
};
struct TailOrder {
    pg8::StaticOrder lat; int G, c, nlat, nctx_tiles, NS, ktiles;
    __device__ __forceinline__ void init(int K, int G_, int c_, bool with_ctx) {
        lat.init(ML, DM, G_, c_); G = G_; c = c_; nlat = (lat.nwg - c_ + G_ - 1) / G_; if (nlat < 0) nlat = 0;
        nctx_tiles = with_ctx ? (MC / 256) * (DM / 256) : 0; ktiles = K / 64; NS = (ktiles == 16) ? 4 : 6;
    }
    __device__ __forceinline__ bool next(int i, pg8::Unit& u) const {
        const bool has_sub = c < nctx_tiles * NS; const int il = has_sub ? 1 : 0;
        pg8::Unit a; const bool okl = lat.next(0, a);
        const int j = c; const int tile = j / NS, sp = j - tile * NS;
        int kt0, n;
        if (ktiles == 16) { kt0 = sp * 4; n = 4; } else { n = sp < 4 ? 8 : 6; kt0 = sp < 4 ? sp * 8 : 32 + (sp - 4) * 6; }
        const bool isl = (i == il);
        u.pm = isl ? a.pm : ML / 256 + (tile >> 2); u.pn = isl ? a.pn : (tile & 3); u.k0b = isl ? 0 : kt0 * 128; u.nt = isl ? 0 : n;
        return isl ? okl : (i < il);
    }
    __device__ __forceinline__ void a_ready(const pg8::Unit&) const {}
    __device__ __forceinline__ void done(const pg8::Unit&) const {}
};
struct EpiRes {
    static constexpr bool PERM = false, AFTER_DRAIN = false;
    float* xl; const float* xsl; const float* xsc; unsigned char* ws; int moff;
    __device__ __forceinline__ void operator()(const pg8::f32x4 (&acc)[2][2][4][2], const pg8::Unit& u, int wr, int wc, int fr, int fq) const {
        const float* modv = (const float*)(ws + WS_MODV) + moff; float* xc = (float*)(ws + WS_XC);
        const bool part = u.nt != 0;
        const int sp = (u.nt == 4) ? (u.k0b >> 9) : (u.k0b < 4096 ? (u.k0b >> 10) : 4 + (u.k0b - 4096) / 768);
        const int row0 = u.pm * 256 + wr * 64 + fr, c0 = u.pn * 256 + wc * 32 + 4 * fq;
        const float* mg = modv + (row0 < ML ? (row0 >> 11) : 8) * 6144 + c0;
        f32x4 gt[2][2];
#pragma unroll
        for (int bj = 0; bj < 2; ++bj) { gt[bj][0] = *(const f32x4*)(mg + bj * 128); gt[bj][1] = *(const f32x4*)(mg + bj * 128 + 16); }
        if (!part) {
            float* xp = xl + (size_t)row0 * 1024 + c0; const float* xq = xsl + (size_t)row0 * 1024 + c0;
#pragma unroll
            for (int ai = 0; ai < 2; ++ai) {
                f32x4 xv[4][2][2];
#pragma unroll
                for (int m = 0; m < 4; ++m)
#pragma unroll
                    for (int bj = 0; bj < 2; ++bj) { const float* q = xq + (size_t)(ai * 128 + m * 16) * 1024 + bj * 128; xv[m][bj][0] = *(const f32x4*)q; xv[m][bj][1] = *(const f32x4*)(q + 16); }
#pragma unroll
                for (int m = 0; m < 4; ++m)
#pragma unroll
                    for (int bj = 0; bj < 2; ++bj) { float* o = xp + (size_t)(ai * 128 + m * 16) * 1024 + bj * 128;
                        *(f32x4*)o = xv[m][bj][0] + gt[bj][0] * acc[ai][bj][m][0]; *(f32x4*)(o + 16) = xv[m][bj][1] + gt[bj][1] * acc[ai][bj][m][1]; }
                asm volatile("" ::: "memory");
            }
        } else {
            float* sl = (float*)(ws + WS_SLAB) + ((size_t)sp * MC + (row0 - ML)) * 1024 + c0;
#pragma unroll
            for (int ai = 0; ai < 2; ++ai)
#pragma unroll
                for (int m = 0; m < 4; ++m)
#pragma unroll
                    for (int bj = 0; bj < 2; ++bj) { float* o = sl + (size_t)(ai * 128 + m * 16) * 1024 + bj * 128;
                        *(f32x4*)o = gt[bj][0] * acc[ai][bj][m][0]; *(f32x4*)(o + 16) = gt[bj][1] * acc[ai][bj][m][1]; }
        }
    }
};
struct EpiResNorm {
    static constexpr bool PERM = false, AFTER_DRAIN = true;
    float* xl; const float* xsl; unsigned char* ws; int moff;
    const float* ngain; int noff; float* fout; unsigned* cnt;
    __device__ __forceinline__ void operator()(const pg8::f32x4 (&acc)[2][2][4][2], const pg8::Unit& u, int wr, int wc, int fr, int fq) const {
        const float* modv = (const float*)(ws + WS_MODV) + moff;
        const int sp = (u.nt == 4) ? (u.k0b >> 9) : (u.k0b < 4096 ? (u.k0b >> 10) : 4 + (u.k0b - 4096) / 768);
        const int row0 = u.pm * 256 + wr * 64 + fr, c0 = u.pn * 256 + wc * 32 + 4 * fq;
        const float* mg = modv + 8 * 6144 + c0;
        f32x4 gt[2][2];
#pragma unroll
        for (int bj = 0; bj < 2; ++bj) { gt[bj][0] = *(const f32x4*)(mg + bj * 128); gt[bj][1] = *(const f32x4*)(mg + bj * 128 + 16); }
        float* sl = (float*)(ws + WS_SLAB) + ((size_t)sp * MC + (row0 - ML)) * 1024 + c0;
#pragma unroll
        for (int ai = 0; ai < 2; ++ai)
#pragma unroll
            for (int m = 0; m < 4; ++m)
#pragma unroll
                for (int bj = 0; bj < 2; ++bj) { float* o = sl + (size_t)(ai * 128 + m * 16) * 1024 + bj * 128;
                    *(f32x4*)o = gt[bj][0] * acc[ai][bj][m][0]; *(f32x4*)(o + 16) = gt[bj][1] * acc[ai][bj][m][1]; }
    }
    __device__ __forceinline__ void fused(pg8::f32x4 (&acc)[2][2][4][2], const pg8::Unit& u, int wr, int wc, int fr, int fq, LAS unsigned char* lds, int wid, int lane) const {
        const float* modv = (const float*)(ws + WS_MODV);
        const int row0 = u.pm * 256 + wr * 64 + fr, c0 = u.pn * 256 + wc * 32 + 4 * fq, bidx = row0 >> 11;
        const bool final_ = noff < 0;
        {
            const float* mg = modv + moff + bidx * 6144 + c0;
            f32x4 gt[2][2];
#pragma unroll
            for (int bj = 0; bj < 2; ++bj) { gt[bj][0] = *(const f32x4*)(mg + bj * 128); gt[bj][1] = *(const f32x4*)(mg + bj * 128 + 16); }
            float* xf = xl + ((size_t)(u.pm * 4 + u.pn) * 32 * 512 + (size_t)(wid * 64 + lane)) * 4;
            const float* xq = xsl ? xsl + (size_t)row0 * 1024 + c0 : nullptr;
#pragma unroll
            for (int ai = 0; ai < 2; ++ai) {
                f32x4 xv[4][2][2];
                if (xq) {
#pragma unroll
                    for (int m = 0; m < 4; ++m)
#pragma unroll
                        for (int bj = 0; bj < 2; ++bj) { const float* q = xq + (size_t)(ai * 128 + m * 16) * 1024 + bj * 128; xv[m][bj][0] = *(const f32x4*)q; xv[m][bj][1] = *(const f32x4*)(q + 16); }
                } else {
#pragma unroll
                    for (int m = 0; m < 4; ++m)
#pragma unroll
                        for (int bj = 0; bj < 2; ++bj) { const float* q = xf + (size_t)((ai * 16 + m * 4 + bj * 2) * 512) * 4; xv[m][bj][0] = *(const f32x4*)q; xv[m][bj][1] = *(const f32x4*)(q + 512 * 4); }
                }
#pragma unroll
                for (int m = 0; m < 4; ++m)
#pragma unroll
                    for (int bj = 0; bj < 2; ++bj) { float* o = xf + (size_t)((ai * 16 + m * 4 + bj * 2) * 512) * 4;
                        acc[ai][bj][m][0] = xv[m][bj][0] + gt[bj][0] * acc[ai][bj][m][0]; acc[ai][bj][m][1] = xv[m][bj][1] + gt[bj][1] * acc[ai][bj][m][1];
                        if (!final_) { *(f32x4*)o = acc[ai][bj][m][0]; *(f32x4*)(o + 512 * 4) = acc[ai][bj][m][1]; } }
                asm volatile("" ::: "memory");
            }
        }
        LAS float* P = (LAS float*)(lds + LDSCTL_OFF + 1024);
        LAS float* S = P + 1024;
        float* slot = (float*)(ws + WS_XSLOT); unsigned* cn = cnt + 64 * u.pm;
#pragma unroll
        for (int ai = 0; ai < 2; ++ai)
#pragma unroll
            for (int m = 0; m < 4; ++m) {
                float s = 0.f;
#pragma unroll
                for (int bj = 0; bj < 2; ++bj)
#pragma unroll
                    for (int n = 0; n < 2; ++n) { const f32x4 x = acc[ai][bj][m][n]; s += (x[0] * x[0] + x[1] * x[1]) + (x[2] * x[2] + x[3] * x[3]); }
                s += __shfl_xor(s, 16); s += __shfl_xor(s, 32);
                if (fq == 0) P[(ai * 128 + wr * 64 + m * 16 + fr) * 4 + wc] = s;
            }
        asm volatile("s_waitcnt lgkmcnt(0)" ::: "memory"); __builtin_amdgcn_s_barrier(); asm volatile("" ::: "memory");
        const int prow = wid * 32 + (lane & 31);
        if (lane < 32) {
            const float tot = (P[prow * 4 + 0] + P[prow * 4 + 1]) + (P[prow * 4 + 2] + P[prow * 4 + 3]);
            __hip_atomic_store((unsigned*)slot + ((size_t)(u.pm * 256 + prow) * 4 + u.pn), __float_as_uint(tot), __ATOMIC_RELAXED, __HIP_MEMORY_SCOPE_AGENT);
        }
        asm volatile("s_waitcnt vmcnt(0)" ::: "memory");
        if (lane == 0) __hip_atomic_fetch_add(cn, 1u, __ATOMIC_RELAXED, __HIP_MEMORY_SCOPE_AGENT);
        if (wid == 0) {
            unsigned sp_ = 0;
            while ((unsigned)__builtin_amdgcn_readfirstlane(__hip_atomic_load(cn, __ATOMIC_RELAXED, __HIP_MEMORY_SCOPE_AGENT)) < 32u) { __builtin_amdgcn_s_sleep(2); if (++sp_ > (1u << 22)) break; }
            __builtin_amdgcn_fence(__ATOMIC_ACQUIRE, "agent");
        }
        asm volatile("s_waitcnt vmcnt(0) lgkmcnt(0)" ::: "memory"); __builtin_amdgcn_s_barrier(); asm volatile("" ::: "memory");
        if (lane < 32) {
            const unsigned* sr = (const unsigned*)slot + (size_t)(u.pm * 256 + prow) * 4;
            float q = 0.f;
#pragma unroll
            for (int t = 0; t < 4; ++t) q += __uint_as_float(__hip_atomic_load(sr + t, __ATOMIC_RELAXED, __HIP_MEMORY_SCOPE_AGENT));
            S[prow] = 1.f / sqrtf(q * (1.f / 1024.f) + NORM_EPS);
        }
        asm volatile("s_waitcnt lgkmcnt(0)" ::: "memory"); __builtin_amdgcn_s_barrier(); asm volatile("" ::: "memory");
        bf16_t* hp = (bf16_t*)(ws + WS_H) + (size_t)row0 * 1024 + c0; float* fo = fout + (size_t)row0 * 1024 + c0;
#pragma unroll
        for (int bj = 0; bj < 2; ++bj) {
            f32x4 mul[2], sh[2];
#pragma unroll
            for (int n = 0; n < 2; ++n) {
                const int c = c0 + bj * 128 + n * 16;
                mul[n] = *(const f32x4*)(ngain + c); sh[n] = (f32x4){0.f, 0.f, 0.f, 0.f};
                if (!final_) { const float* mv = modv + noff + bidx * 6144 + c; sh[n] = *(const f32x4*)mv; mul[n] = mul[n] * (*(const f32x4*)(mv + 1024) + 1.f); }
            }
#pragma unroll
            for (int ai = 0; ai < 2; ++ai)
#pragma unroll
                for (int m = 0; m < 4; ++m) {
                    const float rs = S[ai * 128 + wr * 64 + m * 16 + fr];
                    const f32x4 y0 = (acc[ai][bj][m][0] * rs) * mul[0] + sh[0], y1 = (acc[ai][bj][m][1] * rs) * mul[1] + sh[1];
                    const size_t off = (size_t)(ai * 128 + m * 16) * 1024 + bj * 128;
                    if (!final_) { st8bf_x(hp + off, y0, y1, fq & 1); }
                    else { *(f32x4*)(fo + off) = y0; *(f32x4*)(fo + off + 16) = y1; }
                }
        }
    }
};
struct EpiE4 {
    static constexpr bool PERM = false, AFTER_DRAIN = false;
    unsigned char* ws;
    __device__ __forceinline__ void operator()(const pg8::f32x4 (&acc)[2][2][4][2], const pg8::Unit& u, int wr, int wc, int fr, int fq) const {
        bf16_t* act = (bf16_t*)(ws + WS_ACT);
        const int c0 = u.pn * 256 + wc * 32 + 4 * fq, oc = ((c0 >> 5) << 4) + (c0 & 15);
        const bool odd = fq & 1;
#pragma unroll
        for (int ai = 0; ai < 2; ++ai)
#pragma unroll
            for (int m = 0; m < 4; ++m) {
                const int row = u.pm * 256 + ai * 128 + wr * 64 + m * 16 + fr;
                f32x4 a, b;
#pragma unroll
                for (int i = 0; i < 4; ++i) { a[i] = siluf_(acc[ai][0][m][0][i]) * acc[ai][0][m][1][i]; b[i] = siluf_(acc[ai][1][m][0][i]) * acc[ai][1][m][1][i]; }
                unsigned a0 = pk2(a[0], a[1]), a1 = pk2(a[2], a[3]), b0 = pk2(b[0], b[1]), b1 = pk2(b[2], b[3]);
                auto r0 = __builtin_amdgcn_permlane16_swap(a0, b0, false, false); a0 = r0[0]; b0 = r0[1];
                auto r1 = __builtin_amdgcn_permlane16_swap(a1, b1, false, false); a1 = r1[0]; b1 = r1[1];
                *(u32x4*)(act + (size_t)row * D_FF + oc + (odd ? 60 : 0)) = (u32x4){a0, a1, b0, b1};
                asm volatile("" ::: "memory");
            }
    }
};
struct E4F {
    unsigned char* ws;
    __device__ __forceinline__ void operator()(int row, int c0, f32x4 v0, f32x4 v1) const {
        bf16_t* act = (bf16_t*)(ws + WS_ACT); f32x4 a;
#pragma unroll
        for (int i = 0; i < 4; ++i) a[i] = siluf_(v0[i]) * v1[i];
        st4bf(act + (size_t)row * D_FF + ((c0 >> 5) << 4) + (c0 & 15), a);
    }
};

template <int MODE> __device__ __forceinline__ void transpose_item(const float* W, int K, int N, bf16_t* WT, LAS float* scr, int item, int lane) {
    const int nblk = N / 32, kb = item / nblk, nb = item % nblk, k0 = 64 * kb, n0 = 32 * nb;
    float wv[32];
#pragma unroll
    for (int i = 0; i < 32; ++i) wv[i] = W[(size_t)(k0 + 2 * i + (lane >> 5)) * N + n0 + (lane & 31)];
#pragma unroll
    for (int i = 0; i < 32; ++i) scr[(2 * i + (lane >> 5)) * 33 + (lane & 31)] = wv[i];
    asm volatile("s_waitcnt lgkmcnt(0)" ::: "memory");
    const int c = lane & 7;
#pragma unroll
    for (int j = 0; j < 4; ++j) { const int n = (lane >> 3) + 8 * j; const LAS float* s = scr + (8 * c) * 33 + n;
        u32x4 o; o.x = pk2(s[0 * 33], s[1 * 33]); o.y = pk2(s[2 * 33], s[3 * 33]); o.z = pk2(s[4 * 33], s[5 * 33]); o.w = pk2(s[6 * 33], s[7 * 33]);
        int drow = n0 + n;
        if (MODE == 1) { const int up = (n0 >= D_FF) ? 16 : 0; const int mm = (n0 >= D_FF ? n0 - D_FF : n0) + n; drow = ((mm >> 4) << 5) + up + (mm & 15); }
        *(u32x4*)(WT + (size_t)drow * K + k0 + 8 * c) = o; }
    asm volatile("s_waitcnt lgkmcnt(0)" ::: "memory");
}

__device__ __forceinline__ void norm_load(f32x4 (&v)[4], const float* xrow, int lane, const float* slab, int npend) {
    const f32x4* xr = (const f32x4*)xrow + lane;
#pragma unroll
    for (int j = 0; j < 4; ++j) v[j] = xr[64 * j];
    if (npend) {
        f32x4 pv[6][4];
#pragma unroll
        for (int sp = 0; sp < 6; ++sp) { const int sc = sp < npend ? sp : npend - 1; const f32x4* pr = (const f32x4*)(slab + (size_t)sc * MC * 1024) + lane;
#pragma unroll
            for (int j = 0; j < 4; ++j) pv[sp][j] = pr[64 * j]; }
#pragma unroll
        for (int sp = 0; sp < 6; ++sp) { const float mk = sp < npend ? 1.f : 0.f;
#pragma unroll
            for (int j = 0; j < 4; ++j) v[j] += pv[sp][j] * mk; }
    }
}
__device__ __forceinline__ void norm_finish(const f32x4 (&v)[4], float* xdst, int npend, const float* gain, const float* shift, const float* scale, bf16_t* orow, int lane) {
    float s = 0.f;
    if (npend) { f32x4* xw = (f32x4*)xdst + lane;
#pragma unroll
        for (int j = 0; j < 4; ++j) xw[64 * j] = v[j]; }
#pragma unroll
    for (int j = 0; j < 4; ++j) s += (v[j][0] * v[j][0] + v[j][1] * v[j][1]) + (v[j][2] * v[j][2] + v[j][3] * v[j][3]);
    const float rstd = 1.f / sqrtf(wave_sum(s) * (1.f / DM) + NORM_EPS);
#pragma unroll
    for (int j = 0; j < 4; ++j) {
        const int c = 4 * lane + 256 * j;
        const f32x4 g = *(const f32x4*)(gain + c), sh = *(const f32x4*)(shift + c), sc = *(const f32x4*)(scale + c);
        f32x4 y = (v[j] * rstd) * g; y = y * (sc + 1.f) + sh;
        st4bf(orow + c, y);
    }
}

constexpr int ATT_KB = 128 * 144, ATT_VB = 64 * 264, ATT_BUF = ATT_KB + ATT_VB;
__device__ __forceinline__ void attn_unit(int unit, LAS unsigned char* lds, const bf16_t* Q, const bf16_t* KB, const bf16_t* VT, bf16_t* Y, const float* sink_l, const int tid) {
    const int lane = tid & 63, wid = __builtin_amdgcn_readfirstlane(tid >> 6), q32 = lane & 31, h = lane >> 5;
    const bool is_ctx = unit >= 256;
    int b, hk, nb; long qrow0;
    if (!is_ctx) { b = unit >> 5; hk = (unit >> 4) & 1; nb = unit & 15; qrow0 = (long)b * SEQ + nb * 128; }
    else { const int u2 = unit - 256; b = u2 >> 2; hk = (u2 >> 1) & 1; nb = u2 & 1; qrow0 = (long)ML + b * CTXL + nb * 128; }
    const int hq = hk * 4 + (wid >> 1);
    const int qpos0 = nb * 128 + (wid & 1) * 64;
    const long qr = qrow0 + (wid & 1) * 64;
    bf16x8 qf[2][4];
#pragma unroll
    for (int qb = 0; qb < 2; ++qb)
#pragma unroll
        for (int s = 0; s < 4; ++s) qf[qb][s] = *(const bf16x8*)(Q + (size_t)(qr + qb * 32 + q32) * 512 + hq * 64 + s * 16 + h * 8);
    const float sink2 = sink_l[hq] * LOG2E;
    float mrun[2] = {sink2, sink2}; float lrun[2]; lrun[0] = lrun[1] = (h == 0) ? 1.f : 0.f;
    f32x16 o[2][2];
#pragma unroll
    for (int a = 0; a < 2; ++a)
#pragma unroll
        for (int d = 0; d < 2; ++d)
#pragma unroll
            for (int r = 0; r < 16; ++r) o[a][d][r] = 0.f;
    int c_lo = 0, nlc = 0;
    if (!is_ctx) { c_lo = nb > 0 ? nb - 1 : 0; const int c_hi = nb < 15 ? nb + 1 : 15; nlc = c_hi - c_lo + 1; }
    const int nch = nlc + 2;
    const int kkey = tid >> 3, kpart = tid & 7, vd = tid >> 4, vpart = tid & 15;
    const bf16_t* kg_l = KB + (size_t)((long)b * SEQ + kkey) * 128 + hk * 64 + kpart * 8;
    const bf16_t* kg_c = KB + (size_t)((long)ML + b * CTXL + kkey) * 128 + hk * 64 + kpart * 8;
    const bf16_t* vg_l = VT + ((size_t)((b * 2 + hk) * 64 + vd)) * SEQ + vpart * 8;
    const bf16_t* vg_c = VT + VT_CTX_OFF + ((size_t)((b * 2 + hk) * 64 + vd)) * CTXL + vpart * 8;
    const int klds = kkey * 144 + kpart * 16, vlds = ATT_KB + vd * 264 + vpart * 16;
    u32x4 kreg[2], vreg[2];
#define ATT_GLOAD(ci) do { const bool loc_ = (ci) < nlc; const int key0_ = loc_ ? (c_lo + (ci)) * 128 : ((ci) - nlc) * 128; \
        const bf16_t* kq_ = (loc_ ? kg_l : kg_c) + (size_t)key0_ * 128; const bf16_t* vq_ = (loc_ ? vg_l : vg_c) + key0_; const size_t vs_ = loc_ ? SEQ : CTXL; \
        kreg[0] = *(const u32x4*)kq_; kreg[1] = *(const u32x4*)(kq_ + 64 * 128); vreg[0] = *(const u32x4*)vq_; vreg[1] = *(const u32x4*)(vq_ + 32 * vs_); } while (0)
#define ATT_LWRITE(buf) do { LAS unsigned char* bb_ = lds + (buf) * ATT_BUF; \
        *(LAS u32x4*)(bb_ + klds) = kreg[0]; *(LAS u32x4*)(bb_ + klds + 64 * 144) = kreg[1]; \
        *(LAS u32x2*)(bb_ + vlds) = (u32x2){vreg[0].x, vreg[0].y}; *(LAS u32x2*)(bb_ + vlds + 8) = (u32x2){vreg[0].z, vreg[0].w}; \
        *(LAS u32x2*)(bb_ + vlds + 32 * 264) = (u32x2){vreg[1].x, vreg[1].y}; *(LAS u32x2*)(bb_ + vlds + 32 * 264 + 8) = (u32x2){vreg[1].z, vreg[1].w}; } while (0)
    ATT_GLOAD(0); ATT_LWRITE(0);
    __syncthreads();
    for (int ci = 0; ci < nch; ++ci) {
        if (ci + 1 < nch) ATT_GLOAD(ci + 1);
        const bool local = ci < nlc; const int key0 = local ? (c_lo + ci) * 128 : 0;
        const LAS unsigned char* kb_ = lds + (ci & 1) * ATT_BUF; const LAS unsigned char* vb_ = kb_ + ATT_KB;
        for (int tt = 0; tt < 4; ++tt) {
            const int kpos = key0 + tt * 32;
            if (local && (kpos + 31 < qpos0 - 128 || kpos > qpos0 + 63 + 128)) continue;
            bf16x8 kf[4], vf[2][2];
#pragma unroll
            for (int s = 0; s < 4; ++s) kf[s] = *(const LAS bf16x8*)(kb_ + (tt * 32 + q32) * 144 + s * 32 + h * 16);
#pragma unroll
            for (int db = 0; db < 2; ++db)
#pragma unroll
                for (int s = 0; s < 2; ++s) {
                    const LAS unsigned char* pv = vb_ + (db * 32 + q32) * 264 + (tt * 32 + s * 16 + h * 4) * 2;
                    const s16x4 lo = *(const LAS s16x4*)pv, hi = *(const LAS s16x4*)(pv + 16);
                    vf[db][s] = (bf16x8){lo[0], lo[1], lo[2], lo[3], hi[0], hi[1], hi[2], hi[3]};
                }
#pragma unroll
            for (int qb = 0; qb < 2; ++qb) {
                bool needmask = false;
                if (local) { const int dq = kpos - (qpos0 + qb * 32); if (dq > 128 || dq < -128) continue; needmask = (dq == 128 || dq == -128); }
                f32x16 sa; const float nm = -mrun[qb];
#pragma unroll
                for (int r = 0; r < 16; ++r) sa[r] = nm;
#pragma unroll
                for (int s = 0; s < 4; ++s) sa = __builtin_amdgcn_mfma_f32_32x32x16_bf16(kf[s], qf[qb][s], sa, 0, 0, 0);
                if (needmask) {
                    const int qpos = qpos0 + qb * 32 + q32;
#pragma unroll
                    for (int r = 0; r < 16; ++r) { const int key = kpos + (r & 3) + 8 * (r >> 2) + 4 * h; const int dd = qpos - key; if (dd > 128 || dd < -128) sa[r] = -INFINITY; }
                }
                float tm = fmaxf(fmaxf(sa[0], sa[1]), sa[2]);
#pragma unroll
                for (int r = 3; r < 15; r += 2) tm = fmaxf(fmaxf(tm, sa[r]), sa[r + 1]);
                tm = fmaxf(tm, sa[15]);
                { const auto rr = __builtin_amdgcn_permlane32_swap(__float_as_uint(tm), __float_as_uint(tm), false, false); tm = fmaxf(__uint_as_float(rr[0]), __uint_as_float(rr[1])); }
                if (__builtin_amdgcn_ballot_w64(tm > 8.f) != 0ull) {
                    const float dl = fmaxf(tm, 0.f); mrun[qb] += dl;
                    const float f = fast_exp2(-dl); lrun[qb] *= f;
#pragma unroll
                    for (int r = 0; r < 16; ++r) sa[r] -= dl;
#pragma unroll
                    for (int db = 0; db < 2; ++db)
#pragma unroll
                        for (int r = 0; r < 16; ++r) o[qb][db][r] *= f;
                }
                float ps0 = 0.f, ps1 = 0.f;
#pragma unroll
                for (int r = 0; r < 16; r += 2) { sa[r] = fast_exp2(sa[r]); sa[r + 1] = fast_exp2(sa[r + 1]); ps0 += sa[r]; ps1 += sa[r + 1]; }
                lrun[qb] += ps0 + ps1;
                bf16x8 pf[2];
#pragma unroll
                for (int s = 0; s < 2; ++s) {
                    u32x4 w; w.x = pk2(sa[8 * s + 0], sa[8 * s + 1]); w.y = pk2(sa[8 * s + 2], sa[8 * s + 3]); w.z = pk2(sa[8 * s + 4], sa[8 * s + 5]); w.w = pk2(sa[8 * s + 6], sa[8 * s + 7]);
                    pf[s] = __builtin_bit_cast(bf16x8, w);
                }
#pragma unroll
                for (int db = 0; db < 2; ++db)
#pragma unroll
                    for (int s = 0; s < 2; ++s) o[qb][db] = __builtin_amdgcn_mfma_f32_32x32x16_bf16(vf[db][s], pf[s], o[qb][db], 0, 0, 0);
            }
        }
        if (ci + 1 < nch) ATT_LWRITE((ci + 1) & 1);
        __syncthreads();
    }
#undef ATT_GLOAD
#undef ATT_LWRITE
#pragma unroll
    for (int qb = 0; qb < 2; ++qb) {
        const float lt = lrun[qb] + __shfl_xor(lrun[qb], 32); const float inv = 1.f / lt;
        bf16_t* yr = Y + (size_t)(qr + qb * 32 + q32) * 512 + hq * 64;
#pragma unroll
        for (int db = 0; db < 2; ++db)
#pragma unroll
            for (int r4 = 0; r4 < 4; r4 += 2) {
                unsigned a0 = pk2(o[qb][db][4 * r4] * inv, o[qb][db][4 * r4 + 1] * inv), a1 = pk2(o[qb][db][4 * r4 + 2] * inv, o[qb][db][4 * r4 + 3] * inv);
                unsigned b0 = pk2(o[qb][db][4 * r4 + 4] * inv, o[qb][db][4 * r4 + 5] * inv), b1 = pk2(o[qb][db][4 * r4 + 6] * inv, o[qb][db][4 * r4 + 7] * inv);
                const auto s0 = __builtin_amdgcn_permlane32_swap(a0, b0, false, false); a0 = s0[0]; b0 = s0[1];
                const auto s1 = __builtin_amdgcn_permlane32_swap(a1, b1, false, false); a1 = s1[0]; b1 = s1[1];
                *(u32x4*)(yr + db * 32 + r4 * 8 + h * 8) = (u32x4){a0, a1, b0, b1};
            }
    }
}

__device__ __forceinline__ void sg_unit(int unit, LAS unsigned char* lds, const bf16_t* SVT, const float* SSQ, const bf16_t* U, bf16_t* YS, const bf16_t* WSP, const float* gain_l, const float* bsp_l, const int tid) {
    const int lane = tid & 63, wid = __builtin_amdgcn_readfirstlane(tid >> 6), fr = lane & 15, fq = lane >> 4;
    const int ci = unit >> 2, g = unit & 3; const long row0 = (long)ci * 128;
    LAS float* rstd = (LAS float*)lds;
    LAS unsigned char* Wp = lds + 512;
    bf16x8 af[4];
#pragma unroll
    for (int ks = 0; ks < 4; ++ks) af[ks] = *(const bf16x8*)(SVT + ((size_t)ci * 512 + g * 128 + 16 * wid + fr) * 128 + ks * 32 + fq * 8);
    if (tid < 128) { const int r = (tid & 64) + 16 * (tid & 3) + ((tid & 63) >> 2);
        rstd[tid] = 1.f / sqrtf(SSQ[row0 + r] * (1.f / 512.f) + NORM_EPS); }
    __syncthreads();
#pragma unroll
    for (int it = 0; it < 4; ++it) {
        const int idx = tid + it * NTHR, pp = idx >> 4, part = idx & 15;
        const u32x4 w = *(const u32x4*)(WSP + (size_t)(g * 128 + pp) * 128 + part * 8);
        const f32x4 r0 = *(const LAS f32x4*)(rstd + part * 8), r1 = *(const LAS f32x4*)(rstd + part * 8 + 4);
        u32x4 o;
        o.x = pk2(bflo(w.x) * r0[0], bfhi(w.x) * r0[1]); o.y = pk2(bflo(w.y) * r0[2], bfhi(w.y) * r0[3]);
        o.z = pk2(bflo(w.z) * r1[0], bfhi(w.z) * r1[1]); o.w = pk2(bflo(w.w) * r1[2], bfhi(w.w) * r1[3]);
        *(LAS u32x4*)(Wp + pp * 272 + part * 16) = o;
    }
    __syncthreads();
    f32x4 acc[8];
#pragma unroll
    for (int pt = 0; pt < 8; ++pt) acc[pt] = (f32x4){0.f, 0.f, 0.f, 0.f};
#pragma unroll
    for (int ks = 0; ks < 4; ++ks)
#pragma unroll
        for (int pt = 0; pt < 8; ++pt) {
            const bf16x8 bfr = *(const LAS bf16x8*)(Wp + (pt * 16 + fr) * 272 + (ks * 32 + fq * 8) * 2);
            acc[pt] = __builtin_amdgcn_mfma_f32_16x16x32_bf16(af[ks], bfr, acc[pt], 0, 0, 0);
        }
    const f32x4 gn = *(const f32x4*)(gain_l + g * 128 + 16 * wid + 4 * fq);
#pragma unroll
    for (int pt = 0; pt < 8; ++pt) {
        const int pp = pt * 16 + fr; const float bias = bsp_l[g * 128 + pp];
        const size_t uo = (size_t)(row0 + pp) * 512 + g * 128 + 16 * wid + 4 * fq;
        const u32x2 uw = *(const u32x2*)(U + uo);
        f32x4 v; v[0] = bflo(uw.x) * (acc[pt][0] * gn[0] + bias); v[1] = bfhi(uw.x) * (acc[pt][1] * gn[1] + bias); v[2] = bflo(uw.y) * (acc[pt][2] * gn[2] + bias); v[3] = bfhi(uw.y) * (acc[pt][3] * gn[3] + bias);
        st4bf(YS + uo, v);
    }
    __syncthreads();
}

template <int GI> __device__ __forceinline__ void pool_pass(unsigned char* ws, int Mrows, long gtid, long NGT) {
    constexpr int HALFW = 1 << GI, R = 4, NW = R + 2 * HALFW - 1;
    const bf16_t* ZP = (const bf16_t*)(ws + WS_ZPOOL); bf16_t* PO = (bf16_t*)(ws + WS_POOLED);
    for (long t = gtid; t < (long)(Mrows / R) * 16; t += NGT) {
        const int row0 = (int)(t >> 4) * R, ch = GI * 16 + ((int)t & 15);
        int s0, L; if (row0 < ML) { s0 = row0 & ~(SEQ - 1); L = SEQ; } else { s0 = ML + ((row0 - ML) & ~(CTXL - 1)); L = CTXL; }
        const int pos0 = row0 - s0;
        u32x4 w[NW];
#pragma unroll
        for (int j = 0; j < NW; ++j) { const int pj = pos0 + j - HALFW; const int pc = pj < 0 ? 0 : (pj >= L ? L - 1 : pj); w[j] = *(const u32x4*)(ZP + (size_t)(s0 + pc) * 512 + ch * 8); }
        float a[8];
#pragma unroll
        for (int i = 0; i < 8; ++i) a[i] = 0.f;
#pragma unroll
        for (int j = 0; j < 2 * HALFW; ++j) { const int pj = pos0 + j - HALFW; const float msk = (pj >= 0 && pj < L) ? 1.f : 0.f;
#pragma unroll
            for (int k = 0; k < 4; ++k) { a[2 * k] += msk * bflo(w[j][k]); a[2 * k + 1] += msk * bfhi(w[j][k]); } }
#pragma unroll
        for (int r = 0; r < R; ++r) {
            const int pos = pos0 + r; const int lo = max(pos - HALFW, 0), hi = min(pos + HALFW, L);
            const float ic = 1.f / (float)(hi - lo);
            const u32x4 sw = w[r + HALFW];
            u32x4 o;
#pragma unroll
            for (int k = 0; k < 4; ++k) o[k] = pk2(a[2 * k] * ic - bflo(sw[k]), a[2 * k + 1] * ic - bfhi(sw[k]));
            *(u32x4*)(PO + (size_t)(row0 + r) * 512 + ch * 8) = o;
            if (r + 1 < R) {
                const int pe = pos0 + r + HALFW, pl = pos0 + r - HALFW; const float me = (pe < L) ? 1.f : 0.f, ml = (pl >= 0) ? 1.f : 0.f;
#pragma unroll
                for (int k = 0; k < 4; ++k) { a[2 * k] += me * bflo(w[r + 2 * HALFW][k]) - ml * bflo(w[r][k]); a[2 * k + 1] += me * bfhi(w[r + 2 * HALFW][k]) - ml * bfhi(w[r][k]); }
            }
        }
    }
}

#ifndef REPMASK
#define REPMASK 0
#endif
#ifndef PHMASK
#define PHMASK 0xffff
#endif
constexpr int NPH = 1 + 8 * DEPTH + 1;

__global__ void __launch_bounds__(NTHR, 2) fwd_megakernel(Params p_formal) {
    extern __shared__ __attribute__((aligned(16))) unsigned char lds_raw[];
    LAS unsigned char* lds = (LAS unsigned char*)lds_raw;
    volatile LAS unsigned* MISC = (volatile LAS unsigned*)(lds + MISC_OFF);
#define MODV ((float*)(p.ws + WS_MODV))
#define ROPE ((float*)(p.ws + WS_ROPE))
#define XC ((float*)(p.ws + WS_XC))
#define WB (p.ws + WS_WB)
#define WIN_T ((bf16_t*)(WB + WB_WIN))
#define WBP_T ((bf16_t*)(WB + WB_WBP))
#define WBA_T ((bf16_t*)(WB + WB_WBA))
#define WBS_T ((bf16_t*)(WB + WB_WBS))
#define WOUT_T ((bf16_t*)(WB + WB_WOUT))
#define WFI_T ((bf16_t*)(WB + WB_WFI))
#define WFO_T ((bf16_t*)(WB + WB_WFO))
#define WSP ((bf16_t*)(WB + WB_WSP))
#define H ((bf16_t*)(p.ws + WS_H))
#define ZPOOL ((bf16_t*)(p.ws + WS_ZPOOL))
#define SV ((bf16_t*)(p.ws + WS_SV))
#define YACC ((float*)(p.ws + WS_YACC))
#define QB ((bf16_t*)(p.ws + WS_Q))
#define KB ((bf16_t*)(p.ws + WS_KB))
#define VT ((bf16_t*)(p.ws + WS_VT))
#define UB ((bf16_t*)(p.ws + WS_U))
#define GATES ((bf16_t*)(p.ws + WS_GATES))
#define ACT ((bf16_t*)(p.ws + WS_ACT))
#define POOLED ((bf16_t*)(p.ws + WS_POOLED))
#define YM ((bf16_t*)(p.ws + WS_YM))
#define YATT ((bf16_t*)(p.ws + WS_YATT))
#define YSG ((bf16_t*)(p.ws + WS_YSG))
#define XL (p.out)


    for (int u = threadIdx.x; u < (LDS_BYTES - LDSCTL_OFF) / 4; u += NTHR) ((LAS unsigned*)(lds + LDSCTL_OFF))[u] = 0u;
    __syncthreads();
    typedef const __attribute__((address_space(4))) Params* KP;
    const int ph_lo = p_formal.ph_lo, ph_hi = p_formal.ph_hi;
    const bool multi = (ph_hi - ph_lo) > 1;
    unsigned* ctl0 = (unsigned*)(p_formal.ws + WS_CTL);
    if (multi) (void)xcd_barrier_post(ctl0 + CW_BAR, MISC + 8);

    for (int ph = ph_lo, rep = 0; ph < ph_hi; ) {
        KP kp = (KP)__builtin_amdgcn_kernarg_segment_ptr(); asm volatile("" : "+s"(kp));
        const __attribute__((address_space(4))) Params& p = *kp;
        int tid = threadIdx.x; asm volatile("" : "+v"(tid));
        int bx = blockIdx.x; asm volatile("" : "+s"(bx));
        int G = gridDim.x; asm volatile("" : "+s"(G));
        const int lane = tid & 63, wave = __builtin_amdgcn_readfirstlane(tid >> 6);
        const int gw = bx * NWAVES + wave, NGW = G * NWAVES;
        const long gtid = (long)bx * NTHR + tid, NGT = (long)G * NTHR;
        if (ph == 1 + 8 * (DEPTH - 1) + 5 && REPMASK == 0) { ++ph; continue; }
        if (ph > ph_lo && rep == 0) {
            if (ph_lo < 0) { cg::this_grid().sync(); }
            else { XcdBarrier bb; bb.bar = (unsigned*)(p.ws + WS_CTL) + CW_BAR; bb.x = xb_xcc_id(); bb.st = MISC + 8; xcd_barrier(bb);
#ifdef BAR2
                xcd_barrier(bb);
#endif
            }
        }
        if (ph == 0) { if constexpr (PHMASK & 1) {
            if (gtid < 1024) {
                const int pos = (int)gtid >> 4, j = (int)gtid & 15;
                const float inv = exp2f(-(float)j * 0.830482023721841f);
                const float ang = (float)pos * inv;
                const float n = rintf(ang * 0.15915494309189535f);
                float r = fmaf(-n, 6.28125f, ang); r = fmaf(-n, 1.9353071795864769e-3f, r);
                const float rev = r * 0.15915494309189535f;
                ROPE[2 * gtid] = __builtin_amdgcn_cosf(rev); ROPE[2 * gtid + 1] = __builtin_amdgcn_sinf(rev);
            }
            {
                LAS float* sc = (LAS float*)lds;
                LAS float* red = (LAS float*)(lds + 36864);
                for (int i = tid; i < 9 * 1024; i += NTHR) { const float v = (i < 8192) ? p.c[i] : p.c_ctx[i - 8192]; sc[i] = siluf_(v); }
                __syncthreads();
                const int cq = tid & 31, ks = tid >> 5;
                for (int unit = bx; unit < DEPTH * 48; unit += G) {
                    const int l = unit / 48, n0 = (unit % 48) * 128;
                    f32x4 acc[9];
#pragma unroll
                    for (int b = 0; b < 9; ++b) acc[b] = (f32x4){0.f, 0.f, 0.f, 0.f};
                    const float* wp = p.w_mod + ((size_t)l * 1024 + ks * 64) * 6144 + n0 + cq * 4;
#pragma unroll 2
                    for (int k4 = 0; k4 < 64; k4 += 4) {
                        const f32x4 w0 = *(const f32x4*)(wp + (size_t)(k4 + 0) * 6144), w1 = *(const f32x4*)(wp + (size_t)(k4 + 1) * 6144),
                                    w2 = *(const f32x4*)(wp + (size_t)(k4 + 2) * 6144), w3 = *(const f32x4*)(wp + (size_t)(k4 + 3) * 6144);
#pragma unroll
                        for (int b = 0; b < 9; ++b) { const f32x4 s4 = *(const LAS f32x4*)(sc + b * 1024 + ks * 64 + k4); acc[b] += w0 * s4[0] + w1 * s4[1] + w2 * s4[2] + w3 * s4[3]; }
                    }
#pragma unroll
                    for (int b = 0; b < 9; ++b) *(LAS f32x4*)(red + (ks * 9 + b) * 128 + cq * 4) = acc[b];
                    __syncthreads();
                    for (int i = tid; i < 9 * 128; i += NTHR) {
                        const int b = i >> 7, cc = i & 127; float sum = p.b_mod[l * 6144 + n0 + cc];
#pragma unroll
                        for (int k2 = 0; k2 < 16; ++k2) sum += red[(k2 * 9 + b) * 128 + cc];
                        MODV[((size_t)l * 9 + b) * 6144 + n0 + cc] = sum;
                    }
                    __syncthreads();
                }
            }
        } } else if (ph == NPH - 1) {
        } else {
            const int l = (ph - 1) >> 3, sub = (ph - 1) & 7;
            const float* modv = MODV + (size_t)l * 9 * 6144;
            const bool lastl = (l == DEPTH - 1);
            const int Mrows = lastl ? ML : MT;
            if (sub == 0 || sub == 5) { if constexpr (PHMASK & 2) {
                if (sub == 0) {
                    LAS float* scr = (LAS float*)(lds + wave * 16384);
                    const float* w_in = p.w_in + (size_t)l * DM * D_IN; const float* wba = p.wba + (size_t)l * 512 * DM; const float* wbs = p.wbs + (size_t)l * 512 * DM;
                    const float* w_out = p.w_out + (size_t)l * DM * DM; const float* wfi = p.wfi + (size_t)l * DM * 2 * D_FF; const float* wfo = p.wfo + (size_t)l * D_FF * DM;
                    constexpr int I_IN = (DM / 64) * (D_IN / 32), I_BR = (512 / 64) * (DM / 32), I_OUT = (DM / 64) * (DM / 32), I_FI = (DM / 64) * (2 * D_FF / 32), I_FO = (D_FF / 64) * (DM / 32);
                    constexpr int NITEMS = I_IN + 2 * I_BR + I_OUT + I_FI + I_FO;
                    for (int it = gw; it < NITEMS; it += NGW) {
                        int r = it;
                        if (r < I_IN) { transpose_item<0>(w_in, DM, D_IN, WIN_T, scr, r, lane); continue; } r -= I_IN;
                        if (r < I_BR) { transpose_item<0>(wba, 512, DM, WBA_T, scr, r, lane); continue; } r -= I_BR;
                        if (r < I_BR) { transpose_item<0>(wbs, 512, DM, WBS_T, scr, r, lane); continue; } r -= I_BR;
                        if (r < I_OUT) { transpose_item<0>(w_out, DM, DM, WOUT_T, scr, r, lane); continue; } r -= I_OUT;
                        if (r < I_FI) { transpose_item<1>(wfi, DM, 2 * D_FF, WFI_T, scr, r, lane); continue; } r -= I_FI;
                        transpose_item<0>(wfo, D_FF, DM, WFO_T, scr, r, lane);
                    }
                    const float* wpool = p.w_pool + (size_t)l * 4 * 128 * 128; const float* pscale = p.pool_scale + (size_t)l * 512; const float* wbp = p.wbp + (size_t)l * 512 * DM;
                    for (int task = gw; task < 256; task += NGW) {
                        const int g = task >> 6, n0 = (task & 63) * 16, fr = lane & 15, fq = lane >> 4;
                        bf16x8 bfr[4]; f32x4 psv[4][2];
#pragma unroll
                        for (int ks = 0; ks < 4; ++ks) {
                            const float* bp = wbp + (size_t)(g * 128 + ks * 32 + fq * 8) * DM + n0 + fr;
                            u32x4 w; w.x = pk2(bp[0], bp[DM]); w.y = pk2(bp[2 * DM], bp[3 * DM]); w.z = pk2(bp[4 * DM], bp[5 * DM]); w.w = pk2(bp[6 * DM], bp[7 * DM]);
                            bfr[ks] = __builtin_bit_cast(bf16x8, w);
                            psv[ks][0] = *(const f32x4*)(pscale + g * 128 + ks * 32 + fq * 8); psv[ks][1] = *(const f32x4*)(pscale + g * 128 + ks * 32 + fq * 8 + 4);
                        }
#pragma unroll 2
                        for (int ct = 0; ct < 8; ++ct) {
                            f32x4 acc = (f32x4){0.f, 0.f, 0.f, 0.f};
#pragma unroll
                            for (int ks = 0; ks < 4; ++ks) {
                                const float* ap = wpool + (size_t)(g * 128 + ct * 16 + fr) * 128 + ks * 32 + fq * 8;
                                const f32x4 a0 = *(const f32x4*)ap * psv[ks][0], a1 = *(const f32x4*)(ap + 4) * psv[ks][1];
                                u32x4 w; w.x = pk2(a0[0], a0[1]); w.y = pk2(a0[2], a0[3]); w.z = pk2(a1[0], a1[1]); w.w = pk2(a1[2], a1[3]);
                                acc = __builtin_amdgcn_mfma_f32_16x16x32_bf16(__builtin_bit_cast(bf16x8, w), bfr[ks], acc, 0, 0, 0);
                            }
                            st4bf(WBP_T + (size_t)(n0 + fr) * 512 + g * 128 + ct * 16 + fq * 4, acc);
                        }
                    }
                    const float* wsp = p.w_sp + (size_t)l * 4 * 128 * 128;
                    for (long i = gtid; i < 4 * 128 * 128 / 2; i += NGT) {
                        const int rp = (int)(2 * i) & 127; const long base = 2 * i - rp;
                        const int r0 = (rp & 64) + 16 * (rp & 3) + ((rp & 63) >> 2), r1 = (rp & 64) + 16 * ((rp + 1) & 3) + (((rp + 1) & 63) >> 2);
                        ((unsigned*)WSP)[i] = pk2(wsp[base + r0], wsp[base + r1]); }
                }
                if (sub == 0) { float* ssq = (float*)(p.ws + WS_SSQ); for (long i = gtid; i < MT; i += NGT) ssq[i] = 0.f; }
                const float* gain = (sub == 0 ? p.n1g : p.n2g) + (size_t)l * DM; const int si = (sub == 0) ? 0 : 3;
                const int nrows = (sub == 0) ? MT : Mrows;
                const int npend = (sub == 5) ? (lastl ? 0 : 4) : (l > 0 ? 6 : 0);
                const int mfirst = (l == 0 && sub == 0) ? 0 : ML;
                for (int m = mfirst + gw; m < nrows; m += NGW) {
                    const float* xrow; float* xdst; const float* mv; int np = 0; f32x4 va[4];
                    if (m < ML) { xdst = XL + (size_t)m * DM; xrow = (l == 0 && sub == 0) ? p.x + (size_t)m * DM : xdst; mv = modv + (m >> 11) * 6144; }
                    else { xdst = XC + (size_t)(m - ML) * DM; xrow = (l == 0) ? p.ctx + (size_t)(m - ML) * DM : xdst; mv = modv + 8 * 6144; np = npend; }
                    norm_load(va, xrow, lane, (const float*)(p.ws + WS_SLAB) + (size_t)(m - ML) * DM, np);
                    norm_finish(va, xdst, np, gain, mv + si * 1024, mv + (si + 1) * 1024, H + (size_t)m * DM, lane);
                }
            } } else if (sub == 1) { if constexpr (PHMASK & 4) {
                pg8::Gemm g{H, WIN_T, Mrows, D_IN, DM}; pg8::StaticOrder S; S.init(Mrows, D_IN, G, bx);
                EpiE1 E{p.ws, 0, 0};
                pg8::gemm_phase<EpiE1, pg8::StaticOrder, true, true>(lds, g, S, E, tid);
                if (lastl) {
                    pg8::Gemm g2{H + (size_t)ML * DM, WIN_T + (size_t)1024 * DM, MC, 256, DM}; pg8::StaticOrder S2; S2.init(MC, 256, G, (G == 256) ? ((bx + 192) & 255) : bx);
                    EpiE1 E2{p.ws, ML, 1024};
                    pg8::gemm_phase<EpiE1, pg8::StaticOrder, true, true>(lds, g2, S2, E2, tid);
                }
            } } else if (sub == 2) { if constexpr (PHMASK & 8) {
                int nrx = (REPMASK >> 8) ? 2 : 1; if (REPMASK >> 8) asm volatile("" : "+s"(nrx)); const int nra = ((REPMASK >> 8) & 1) ? nrx : 1, nrs = ((REPMASK >> 9) & 1) ? nrx : 1, nrp = ((REPMASK >> 10) & 1) ? nrx : 1;
                for (int rr = 0; rr < nra; ++rr)
                for (int unit = bx; unit < (lastl ? 256 : 288); unit += G) attn_unit(unit, lds, QB, KB, VT, YATT, p.sink + l * 8, tid);
                __syncthreads();
                for (int rr = 0; rr < nrs; ++rr)
                for (int unit = G - 1 - bx; unit < (Mrows / 128) * 4; unit += G) sg_unit(unit, lds, SV, (const float*)(p.ws + WS_SSQ), UB, YSG, WSP, p.sgg + (size_t)l * 512, p.b_sp + (size_t)l * 512, tid);
                const int pskip = (!lastl && G > 64) ? 32 : 0; const long pg0 = gtid - (long)pskip * NTHR, pgn = NGT - (long)pskip * NTHR;
                if (pg0 >= 0) for (int rr = 0; rr < nrp; ++rr) { pool_pass<0>(p.ws, Mrows, pg0, pgn); pool_pass<1>(p.ws, Mrows, pg0, pgn); pool_pass<2>(p.ws, Mrows, pg0, pgn); pool_pass<3>(p.ws, Mrows, pg0, pgn); }
            } } else if (sub == 3) { if constexpr (PHMASK & 16) {
                pg8::StaticOrder S; S.init(Mrows, 2 * DM, G, bx);
                pg8::Gemm3 g{POOLED, YATT, YSG, WBP_T, WBA_T, WBS_T, Mrows, DM, 512};
                E2H E{p.ws};
                pg8::gemm_phase_h1<E2H, pg8::StaticOrder>(lds, g, S, E, tid);
            } } else if (sub == 4 || sub == 7) { if constexpr (PHMASK & 32) {
                pg8::Gemm g{sub == 4 ? YM : ACT, sub == 4 ? WOUT_T : WFO_T, Mrows, DM, sub == 4 ? DM : D_FF}; TailOrder S; S.init(sub == 4 ? DM : D_FF, G, bx, !lastl);
                const int moff_ = l * 9 * 6144 + (sub == 4 ? 2 : 5) * 1024;
                const bool l0 = (l == 0 && sub == 4);
                const float* ngain_ = (sub == 4) ? p.n2g + (size_t)l * DM : (lastl ? p.fgain : p.n1g + (size_t)(l + 1) * DM);
                const int noff_ = (sub == 4) ? l * 9 * 6144 + 3 * 1024 : (lastl ? -1 : (l + 1) * 9 * 6144);
                unsigned* cnt_ = (unsigned*)(p.ws + WS_CTL) + CW_XCNT + ((l * 2 + (sub == 4 ? 0 : 1)) * 64) * 64;
                EpiResNorm E{(float*)(p.ws + WS_XF), l0 ? p.x : (const float*)nullptr, p.ws, moff_, ngain_, noff_, XL, cnt_};
                pg8::gemm_phase<EpiResNorm, TailOrder, true, true>(lds, g, S, E, tid);
            } } else { if constexpr (PHMASK & 64) {
                pg8::Gemm g{H, WFI_T, Mrows, 2 * D_FF, DM}; pg8::StaticOrder S; S.init(Mrows, 2 * D_FF, G, bx);
                EpiE4 E{p.ws};
                pg8::gemm_phase<EpiE4, pg8::StaticOrder, true, true>(lds, g, S, E, tid);
            } }
        }
        if (REPMASK != 0 && rep == 0 && ph > 0 && ph < NPH - 1 && ((REPMASK >> ((ph - 1) & 7)) & 1)) rep = 1; else { rep = 0; ++ph; }
    }
}

extern "C" void kernel_launch(void* const* d_in, const int* in_sizes, int n_in, void* d_out, int out_size, void* d_ws, size_t ws_size, hipStream_t stream) {
    static int grid = 0;
    if (grid == 0) {
        if (n_in != 22 || out_size != ML * DM || ws_size < WS_END) { fprintf(stderr, "kernel_launch: unexpected shapes: n_in %d out %d ws %zu (need %zu)\n", n_in, out_size, ws_size, (size_t)WS_END); grid = -1; return; }
        int dev = 0, cus = 0, per_cu = 0;
        if (hipGetDevice(&dev) != hipSuccess || hipDeviceGetAttribute(&cus, hipDeviceAttributeMultiprocessorCount, dev) != hipSuccess) { grid = -1; return; }
        if (hipFuncSetAttribute((const void*)fwd_megakernel, hipFuncAttributeMaxDynamicSharedMemorySize, LDS_BYTES) != hipSuccess) { fprintf(stderr, "kernel_launch: hipFuncSetAttribute failed\n"); grid = -1; return; }
        if (hipOccupancyMaxActiveBlocksPerMultiprocessor(&per_cu, (const void*)fwd_megakernel, NTHR, LDS_BYTES) != hipSuccess || per_cu < 1) { fprintf(stderr, "kernel_launch: occupancy query says %d\n", per_cu); per_cu = 1; }
        (void)hipGetLastError();
        grid = cus * 1;
        fprintf(stderr, "kernel_launch: cus %d per_cu %d grid %d\n", cus, per_cu, grid);
    }
    if (grid < 0) return;
    (void)hipMemsetAsync((char*)d_ws + WS_CTL, 0, CTL_ZERO_BYTES, stream);
    Params p{};
    const float** pp = (const float**)&p;
    for (int i = 0; i < 22; ++i) pp[i] = (const float*)d_in[i];
    p.out = (float*)d_out; p.ws = (unsigned char*)d_ws;
#if MK_ONE_LAUNCH
    p.ph_lo = 0; p.ph_hi = NPH - 1;
    void* args[] = {&p};
    hipError_t e = hipLaunchCooperativeKernel((const void*)fwd_megakernel, dim3(grid), dim3(NTHR), args, LDS_BYTES, stream);
    if (e != hipSuccess) fprintf(stderr, "kernel_launch: cooperative launch failed: %s (grid %d)\n", hipGetErrorString(e), grid);
#else
    for (int ph = 0; ph < NPH; ++ph) {
        p.ph_lo = ph; p.ph_hi = ph + 1;
        hipLaunchKernelGGL(fwd_megakernel, dim3(grid), dim3(NTHR), LDS_BYTES, stream, p);
    }
#endif
}
```
